# Optimizing an MI355X kernel written in HIP

```python
import jax, jax.numpy as jnp
from jax import lax
import numpy as np

D_MODEL = 2048
BATCH = 8
SEQ = 2048
DEPTH = 2

CTX_LEN = 256
GRID_W = 64
N_MIXERS = 2
Q_BLOCK = 128
ROPE_THETA = 10000.0
EPS = 1e-6
N_MOD = 6

MLA_HEADS = 16
MLA_Q_RANK = 768
MLA_KV_RANK = 512
MLA_NOPE = 128
MLA_ROPE = 64
MLA_QK = MLA_NOPE + MLA_ROPE
MLA_V = 128

GQA_HEADS = 16
GQA_KV_HEADS = 4
GQA_REP = GQA_HEADS // GQA_KV_HEADS
GQA_HEAD_DIM = 128

N_EXPERTS = 64
N_EXPERT_GROUPS = 8
TOPK_GROUPS = 4
TOP_K = 8
D_EXPERT = 512
D_SHARED = 512
ROUTED_SCALE = 2.5
MOE_BLOCK = 128

N_LAYERS_A = (DEPTH + N_MIXERS - 1) // N_MIXERS
N_LAYERS_B = DEPTH // N_MIXERS

kernel_name = "hybrid_mla_gqa_moe_diffusion_trunk"


def rms_norm(x, gain):
    xf = x.astype(jnp.float32)
    y = xf * lax.rsqrt(jnp.mean(xf * xf, axis=-1, keepdims=True) + EPS)
    return (y * gain.astype(jnp.float32)).astype(x.dtype)


def modulate(h, shift, scale):
    return h * (1.0 + scale) + shift


def axial_rope_tables(n_tokens, rot_dim):
    rows = n_tokens // GRID_W
    row = jnp.repeat(jnp.arange(rows, dtype=jnp.float32), GRID_W)
    col = jnp.tile(jnp.arange(GRID_W, dtype=jnp.float32), rows)
    half = rot_dim // 2
    inv_freq = ROPE_THETA ** (-jnp.arange(0, half, 2, dtype=jnp.float32) / half)
    ang_r = row[:, None] * inv_freq[None, :]
    ang_c = col[:, None] * inv_freq[None, :]
    ang = jnp.concatenate([ang_r, ang_r, ang_c, ang_c], axis=-1)
    return jnp.cos(ang), jnp.sin(ang)


def rotate_axial_halves(x):
    x1, x2, x3, x4 = jnp.split(x, 4, axis=-1)
    return jnp.concatenate([-x2, x1, -x4, x3], axis=-1)


def apply_rope(x, cos, sin):
    shape = (1, cos.shape[0]) + (1,) * (x.ndim - 3) + (cos.shape[-1],)
    c = cos.reshape(shape).astype(x.dtype)
    s = sin.reshape(shape).astype(x.dtype)
    return x * c + rotate_axial_halves(x) * s


def blocked_attention(q, k, v, scale):
    b, t, g, r, dh = q.shape
    nb = t // Q_BLOCK
    qb = jnp.moveaxis(q.reshape(b, nb, Q_BLOCK, g, r, dh), 1, 0)
    kf = k.astype(jnp.float32)
    vf = v.astype(jnp.float32)

    def one_block(q_blk):
        s = jnp.einsum('bqgrd,bkgd->bgrqk', q_blk.astype(jnp.float32), kf) * scale
        p = jax.nn.softmax(s, axis=-1)
        return jnp.einsum('bgrqk,bkgv->bqgrv', p, vf).astype(q.dtype)

    o = lax.map(one_block, qb)
    return jnp.moveaxis(o, 0, 1).reshape(b, t, g, r, v.shape[-1])


def mla_mixer(a_lat, a_ctx, cos, sin, w_down, g_q, g_kv, w_uq, w_ukv, g_qn, g_kn, w_o, with_ctx):
    def project(h, rotate):
        b, t, _ = h.shape
        down = h @ w_down
        cq = rms_norm(down[..., :MLA_Q_RANK], g_q)
        c_kv = rms_norm(down[..., MLA_Q_RANK:MLA_Q_RANK + MLA_KV_RANK], g_kv)
        k_rope = down[..., MLA_Q_RANK + MLA_KV_RANK:]
        q = (cq @ w_uq).reshape(b, t, MLA_HEADS, MLA_QK)
        kv = (c_kv @ w_ukv).reshape(b, t, MLA_HEADS, MLA_NOPE + MLA_V)
        k = jnp.concatenate(
            [kv[..., :MLA_NOPE],
             jnp.broadcast_to(k_rope[:, :, None, :], (b, t, MLA_HEADS, MLA_ROPE))], axis=-1)
        v = kv[..., MLA_NOPE:]
        q, k = rms_norm(q, g_qn), rms_norm(k, g_kn)
        if rotate:
            q = jnp.concatenate([q[..., :MLA_NOPE], apply_rope(q[..., MLA_NOPE:], cos, sin)], axis=-1)
            k = jnp.concatenate([k[..., :MLA_NOPE], apply_rope(k[..., MLA_NOPE:], cos, sin)], axis=-1)
        return q, k, v

    scale = MLA_QK ** -0.5
    b, t = a_lat.shape[:2]
    q_l, k_l, v_l = project(a_lat, True)
    q_c, k_c, v_c = project(a_ctx, False)
    k_all = jnp.concatenate([k_c, k_l], axis=1)
    v_all = jnp.concatenate([v_c, v_l], axis=1)
    o_lat = blocked_attention(q_l[:, :, :, None], k_all, v_all, scale).reshape(b, t, -1) @ w_o
    o_ctx = None
    if with_ctx:
        o_ctx = blocked_attention(q_c[:, :, :, None], k_c, v_c, scale).reshape(b, a_ctx.shape[1], -1) @ w_o
    return o_lat, o_ctx


def gqa_mixer(a_lat, a_ctx, cos, sin, w_qkv, g_qn, g_kn, w_o, with_ctx):
    nq = GQA_HEADS * GQA_HEAD_DIM
    nk = GQA_KV_HEADS * GQA_HEAD_DIM

    def project(h, rotate):
        b, t, _ = h.shape
        qkv = h @ w_qkv
        q = rms_norm(qkv[..., :nq].reshape(b, t, GQA_KV_HEADS, GQA_REP, GQA_HEAD_DIM), g_qn)
        k = rms_norm(qkv[..., nq:nq + nk].reshape(b, t, GQA_KV_HEADS, GQA_HEAD_DIM), g_kn)
        v = qkv[..., nq + nk:].reshape(b, t, GQA_KV_HEADS, GQA_HEAD_DIM)
        if rotate:
            q, k = apply_rope(q, cos, sin), apply_rope(k, cos, sin)
        return q, k, v

    scale = GQA_HEAD_DIM ** -0.5
    b, t = a_lat.shape[:2]
    q_l, k_l, v_l = project(a_lat, True)
    q_c, k_c, v_c = project(a_ctx, False)
    k_all = jnp.concatenate([k_c, k_l], axis=1)
    v_all = jnp.concatenate([v_c, v_l], axis=1)
    o_lat = blocked_attention(q_l, k_all, v_all, scale).reshape(b, t, -1) @ w_o
    o_ctx = None
    if with_ctx:
        o_ctx = blocked_attention(q_c, k_c, v_c, scale).reshape(b, a_ctx.shape[1], -1) @ w_o
    return o_lat, o_ctx


def swiglu(h, w_gate, w_up, w_down):
    return (jax.nn.silu(h @ w_gate) * (h @ w_up)) @ w_down


def route(h, w_router, b_router):
    n = h.shape[0]
    scores = jax.nn.sigmoid(h.astype(jnp.float32) @ w_router.astype(jnp.float32))
    biased = scores + b_router.astype(jnp.float32)
    grouped = biased.reshape(n, N_EXPERT_GROUPS, N_EXPERTS // N_EXPERT_GROUPS)
    group_score = jnp.sum(lax.top_k(grouped, 2)[0], axis=-1)
    _, top_groups = lax.top_k(group_score, TOPK_GROUPS)
    group_mask = jnp.any(top_groups[:, :, None] == jnp.arange(N_EXPERT_GROUPS)[None, None, :], axis=1)
    expert_mask = jnp.repeat(group_mask, N_EXPERTS // N_EXPERT_GROUPS, axis=-1)
    _, idx = lax.top_k(jnp.where(expert_mask, biased, -jnp.inf), TOP_K)
    w = jnp.take_along_axis(scores, idx, axis=-1)
    w = w / jnp.sum(w, axis=-1, keepdims=True) * ROUTED_SCALE
    return idx.astype(jnp.int32), w


def routed_experts(h, idx, wts, w_gate, w_up, w_down):
    n, d = h.shape
    a = n * TOP_K
    e_flat = idx.reshape(-1)
    tok_flat = jnp.repeat(jnp.arange(n, dtype=jnp.int32), TOP_K)
    w_flat = wts.reshape(-1)
    order = jnp.argsort(e_flat)
    e_s, tok_s, w_s = e_flat[order], tok_flat[order], w_flat[order]
    counts = jnp.bincount(e_flat, length=N_EXPERTS).astype(jnp.int32)
    padded = (counts + MOE_BLOCK - 1) // MOE_BLOCK * MOE_BLOCK
    start = jnp.cumsum(counts) - counts
    pad_end = jnp.cumsum(padded)
    pad_start = pad_end - padded
    dest = pad_start[e_s] + jnp.arange(a, dtype=jnp.int32) - start[e_s]
    n_blocks = -(-(a + N_EXPERTS * (MOE_BLOCK - 1)) // MOE_BLOCK)
    cap = n_blocks * MOE_BLOCK
    tok_buf = jnp.full((cap,), n, jnp.int32).at[dest].set(tok_s)
    w_buf = jnp.zeros((cap,), h.dtype).at[dest].set(w_s.astype(h.dtype))
    block_start = jnp.arange(n_blocks, dtype=jnp.int32) * MOE_BLOCK
    block_expert = jnp.minimum(jnp.searchsorted(pad_end, block_start, side='right'), N_EXPERTS - 1)
    h_pad = jnp.concatenate([h, jnp.zeros((1, d), h.dtype)], axis=0)

    def one_block(args):
        toks, wb, e = args
        xb = h_pad[toks]
        return swiglu(xb, w_gate[e], w_up[e], w_down[e]) * wb[:, None]

    y = lax.map(one_block, (tok_buf.reshape(n_blocks, MOE_BLOCK),
                            w_buf.reshape(n_blocks, MOE_BLOCK), block_expert))
    return jnp.zeros((n + 1, d), h.dtype).at[tok_buf].add(y.reshape(cap, d))[:n]


def moe_ffn(h, w_router, b_router, w_gate, w_up, w_down, ws_gate, ws_up, ws_down):
    shp = h.shape
    hf = h.reshape(-1, shp[-1])
    idx, wts = route(hf, w_router, b_router)
    routed = routed_experts(hf, idx, wts, w_gate, w_up, w_down)
    shared = swiglu(hf, ws_gate, ws_up, ws_down)
    return (routed + shared).reshape(shp)


def setup_inputs(seed: int = 0) -> dict:
    key = jax.random.key(seed)
    ks = jax.random.split(key, 32)
    f32 = jnp.float32
    D = D_MODEL

    def nrm(k, shape, fan_in, gain=1.0):
        return jax.random.normal(k, shape, f32) * (gain * fan_in ** -0.5)

    def gain_(k, shape):
        return 1.0 + 0.05 * jax.random.normal(k, shape, f32)

    return {
        "x": jax.random.normal(ks[0], (BATCH, SEQ, D), f32),
        "c": jax.random.normal(ks[1], (BATCH, D), f32),
        "ctx": jax.random.normal(ks[2], (BATCH, CTX_LEN, D), f32),
        "c_ctx": jax.random.normal(ks[3], (D,), f32),
        "ada_w": nrm(ks[4], (DEPTH, D, N_MOD * D), D, 0.5),
        "ada_b": 0.01 * jax.random.normal(ks[5], (DEPTH, N_MOD * D), f32),
        "norm1_g": gain_(ks[6], (DEPTH, D)),
        "norm2_g": gain_(ks[7], (DEPTH, D)),
        "mla_w_down": nrm(ks[8], (N_LAYERS_A, D, MLA_Q_RANK + MLA_KV_RANK + MLA_ROPE), D),
        "mla_g_q": gain_(ks[9], (N_LAYERS_A, MLA_Q_RANK)),
        "mla_g_kv": gain_(ks[10], (N_LAYERS_A, MLA_KV_RANK)),
        "mla_w_uq": nrm(ks[11], (N_LAYERS_A, MLA_Q_RANK, MLA_HEADS * MLA_QK), MLA_Q_RANK),
        "mla_w_ukv": nrm(ks[12], (N_LAYERS_A, MLA_KV_RANK, MLA_HEADS * (MLA_NOPE + MLA_V)), MLA_KV_RANK),
        "mla_g_qn": gain_(ks[13], (N_LAYERS_A, MLA_QK)),
        "mla_g_kn": gain_(ks[14], (N_LAYERS_A, MLA_QK)),
        "mla_w_o": nrm(ks[15], (N_LAYERS_A, MLA_HEADS * MLA_V, D), MLA_HEADS * MLA_V),
        "gqa_w_qkv": nrm(ks[16], (N_LAYERS_B, D, (GQA_HEADS + 2 * GQA_KV_HEADS) * GQA_HEAD_DIM), D),
        "gqa_g_qn": gain_(ks[17], (N_LAYERS_B, GQA_HEAD_DIM)),
        "gqa_g_kn": gain_(ks[18], (N_LAYERS_B, GQA_HEAD_DIM)),
        "gqa_w_o": nrm(ks[19], (N_LAYERS_B, GQA_HEADS * GQA_HEAD_DIM, D), GQA_HEADS * GQA_HEAD_DIM),
        "moe_w_router": nrm(ks[20], (DEPTH, D, N_EXPERTS), D),
        "moe_b_router": 0.01 * jax.random.normal(ks[21], (DEPTH, N_EXPERTS), f32),
        "moe_w_gate": nrm(ks[22], (DEPTH, N_EXPERTS, D, D_EXPERT), D),
        "moe_w_up": nrm(ks[23], (DEPTH, N_EXPERTS, D, D_EXPERT), D),
        "moe_w_down": nrm(ks[24], (DEPTH, N_EXPERTS, D_EXPERT, D), D_EXPERT),
        "moe_ws_gate": nrm(ks[25], (DEPTH, D, D_SHARED), D),
        "moe_ws_up": nrm(ks[26], (DEPTH, D, D_SHARED), D),
        "moe_ws_down": nrm(ks[27], (DEPTH, D_SHARED, D), D_SHARED),
    }


def reference(x, c, ctx, c_ctx, ada_w, ada_b, norm1_g, norm2_g,
              mla_w_down, mla_g_q, mla_g_kv, mla_w_uq, mla_w_ukv, mla_g_qn, mla_g_kn, mla_w_o,
              gqa_w_qkv, gqa_g_qn, gqa_g_kn, gqa_w_o,
              moe_w_router, moe_b_router, moe_w_gate, moe_w_up, moe_w_down,
              moe_ws_gate, moe_ws_up, moe_ws_down):
    n_lat = x.shape[1]
    n_ctx = ctx.shape[1]
    cos_a, sin_a = axial_rope_tables(n_lat, MLA_ROPE)
    cos_b, sin_b = axial_rope_tables(n_lat, GQA_HEAD_DIM)
    h_lat, h_ctx = x, ctx
    for i in range(DEPTH):
        with_ctx = i < DEPTH - 1
        mod_lat = (jax.nn.silu(c) @ ada_w[i] + ada_b[i])[:, None, :]
        mod_ctx = jax.nn.silu(c_ctx) @ ada_w[i] + ada_b[i]
        sh1, sc1, gt1, sh2, sc2, gt2 = jnp.split(mod_lat, N_MOD, axis=-1)
        csh1, csc1, cgt1, csh2, csc2, cgt2 = jnp.split(mod_ctx, N_MOD, axis=-1)

        a_lat = modulate(rms_norm(h_lat, norm1_g[i]), sh1, sc1)
        a_ctx = modulate(rms_norm(h_ctx, norm1_g[i]), csh1, csc1)
        j = i // N_MIXERS
        if i % N_MIXERS == 0:
            o_lat, o_ctx = mla_mixer(a_lat, a_ctx, cos_a, sin_a, mla_w_down[j], mla_g_q[j], mla_g_kv[j],
                                     mla_w_uq[j], mla_w_ukv[j], mla_g_qn[j], mla_g_kn[j], mla_w_o[j],
                                     with_ctx)
        else:
            o_lat, o_ctx = gqa_mixer(a_lat, a_ctx, cos_b, sin_b, gqa_w_qkv[j], gqa_g_qn[j], gqa_g_kn[j],
                                     gqa_w_o[j], with_ctx)
        h_lat = h_lat + gt1 * o_lat

        f_lat = modulate(rms_norm(h_lat, norm2_g[i]), sh2, sc2)
        moe_args = (moe_w_router[i], moe_b_router[i], moe_w_gate[i], moe_w_up[i], moe_w_down[i],
                    moe_ws_gate[i], moe_ws_up[i], moe_ws_down[i])
        if with_ctx:
            h_ctx = h_ctx + cgt1 * o_ctx
            f_ctx = modulate(rms_norm(h_ctx, norm2_g[i]), csh2, csc2)
            y = moe_ffn(jnp.concatenate([f_ctx, f_lat], axis=1), *moe_args)
            h_ctx = h_ctx + cgt2 * y[:, :n_ctx]
            h_lat = h_lat + gt2 * y[:, n_ctx:]
        else:
            h_lat = h_lat + gt2 * moe_ffn(f_lat, *moe_args)
    return h_lat
```

```cpp
#include <hip/hip_runtime.h>
#include <cstdio>
#include <cstdint>

#ifndef MK_PER_PHASE
#define MK_PER_PHASE 0
#endif

#define LAS __attribute__((address_space(3)))
typedef unsigned short bf16;
typedef short bf16x8 __attribute__((ext_vector_type(8)));
typedef short s16x4 __attribute__((ext_vector_type(4)));
typedef float f32x4 __attribute__((ext_vector_type(4)));
typedef float f32x16 __attribute__((ext_vector_type(16)));
typedef float f32x2 __attribute__((ext_vector_type(2)));
typedef unsigned u32x4 __attribute__((ext_vector_type(4)));
typedef unsigned u32x2 __attribute__((ext_vector_type(2)));
typedef int v4i32 __attribute__((ext_vector_type(4)));
typedef int v8i32 __attribute__((ext_vector_type(8)));

constexpr int DM = 2048, NBATCH = 8, SEQ = 2048, CTXL = 256, TPB = SEQ + CTXL  , MT = NBATCH * TPB  ;
constexpr int NPAN = MT / 256  , NPAN_LAT = NBATCH * SEQ / 256  ;
constexpr int NMOD = 6 * DM;
constexpr int NEXP = 64, TOPK = 8, DEXP = 512;
constexpr int CAP = MT;
constexpr int MAXBLK = MT * TOPK / 256 + NEXP + NPAN;
constexpr float EPS = 1e-6f;
constexpr int NWAVES = 8, NTHREADS = 512;

constexpr size_t MiB = 1u << 20;
constexpr size_t WS_CTL = 0, CTL_BYTES = 2 * MiB;
constexpr int CW_BAR = 1024;
constexpr int CW_CNT = 8192, CNT_STRIDE = 64;
constexpr size_t CTL_MOD = 64 * 1024;
constexpr size_t WS_BT_DOWN = 2 * MiB;
constexpr size_t WS_BT_UQ = WS_BT_DOWN + (size_t)1536 * 2048 * 2;
constexpr size_t WS_BT_UKV = WS_BT_UQ + (size_t)3072 * 768 * 2;
constexpr size_t WS_BT_WO0 = WS_BT_UKV + (size_t)4096 * 512 * 2;
constexpr size_t WS_BT_QKV = WS_BT_WO0 + (size_t)2048 * 2048 * 2;
constexpr size_t WS_BT_WO1 = WS_BT_QKV + (size_t)3072 * 2048 * 2;
constexpr size_t WS_BT_S1 = WS_BT_WO1 + (size_t)2048 * 2048 * 2;
constexpr size_t WS_BT_S2 = WS_BT_S1 + (size_t)2 * 1024 * 2048 * 2;
constexpr size_t WS_BT_R = WS_BT_S2 + (size_t)2 * 2048 * 512 * 2;
constexpr size_t WS_SMALL_END = WS_BT_R + (size_t)2 * 256 * 2048 * 2;
static_assert(WS_SMALL_END <= 64 * MiB, "small weights");
constexpr size_t WS_MOE1 = 64 * MiB;
constexpr size_t WS_F8 = 320 * MiB;
constexpr size_t WS_MOE2 = 576 * MiB;
constexpr float W1_SCALE = 64.f, W2_SCALE = 32.f, ACT_SCALE = 8.f, ACT_SCALE_R = 16.f, Y_SCALE = 32.f, O_SCALE = 8.f;
constexpr size_t WS_H = 832 * MiB;
constexpr size_t WS_ACT = 976 * MiB;
constexpr size_t WS_LOGIT = 1156 * MiB;
constexpr size_t WS_LIST = WS_LOGIT + (size_t)MT * 64 * 4;
constexpr size_t WS_WLIST = WS_LIST + (size_t)NEXP * CAP * 4;
constexpr size_t WS_IDENT = 400 * MiB;
constexpr int IDENT_OFF = (int)(((long long)WS_IDENT - (long long)WS_LIST) / 4);
constexpr size_t WS_ASG = WS_WLIST + (size_t)NEXP * CAP * 4;
constexpr size_t WS_SSQP = WS_ASG + (size_t)MT * 8 * 4;
static_assert(WS_SSQP + (size_t)MT * 24 * 4 <= 1176 * MiB, "misc");
constexpr size_t WS_ARENA = 1176 * MiB;
constexpr size_t AR_A = 0;
constexpr size_t AR_DOWN = 72 * MiB;
constexpr size_t AR_QRAW = 126 * MiB;
constexpr size_t AR_KVRAW = 234 * MiB;
constexpr size_t AR_QF = 378 * MiB;
constexpr size_t AR_KF = 486 * MiB;
constexpr size_t AR_LOGIT4 = 378 * MiB;
constexpr size_t AR_O = 594 * MiB;
constexpr size_t AR_Y = 0;
constexpr size_t AR_YS = 400 * MiB;
constexpr size_t ACT_S_OFF = 96 * MiB;
constexpr size_t WS_END = WS_ARENA + (size_t)MAXBLK * 256 * 2048 * 2;
static_assert(WS_END <= 2048 * MiB, "workspace");

constexpr int LDS_MISC = 136 * 1024;
constexpr int LDS_BYTES = 144 * 1024;

__device__ __forceinline__ unsigned cvt_pk_bf16(float lo, float hi) { unsigned r; asm volatile("v_cvt_pk_bf16_f32 %0, %1, %2" : "=v"(r) : "v"(lo), "v"(hi)); return r; }
__device__ __forceinline__ float bf_lo(unsigned w) { return __uint_as_float(w << 16); }
__device__ __forceinline__ float bf_hi(unsigned w) { return __uint_as_float(w & 0xffff0000u); }
__device__ __forceinline__ float wave_sum(float v) {
#pragma unroll
    for (int o = 1; o < 64; o <<= 1) v += __shfl_xor(v, o);
    return v;
}
__device__ __forceinline__ int lane_id() { return (int)__builtin_amdgcn_mbcnt_hi(~0u, __builtin_amdgcn_mbcnt_lo(~0u, 0u)); }
#define LDS_WAIT() asm volatile("s_waitcnt lgkmcnt(0)" ::: "memory")
#define VM_WAIT() asm volatile("s_waitcnt vmcnt(0)" ::: "memory")

#define XB_TMO      128
#define XB_XCNT(j)  (256  + 64 * (j))
#define XB_XSUB(j)  (1280 + 64 * (j))
#define XB_XGEN(j)  (2304 + 64 * (j))
#define XB_TOP      3328
#define XB_TOPGEN   3392
#define XCD_BAR_WORDS 3456
#define XB_SPIN_CAP (1u << 18)
__device__ __forceinline__ unsigned xb_ld(unsigned* p)              { return __hip_atomic_load(p, __ATOMIC_RELAXED, __HIP_MEMORY_SCOPE_AGENT); }
__device__ __forceinline__ unsigned xb_add(unsigned* p, unsigned v) { return __hip_atomic_fetch_add(p, v, __ATOMIC_RELAXED, __HIP_MEMORY_SCOPE_AGENT); }
__device__ __forceinline__ unsigned xb_xcc_id() { return (unsigned)__builtin_amdgcn_s_getreg((3 << 11) | 20) & 0xFu; }
#define XB_SPIN(cond, bar) do { unsigned _sp = 0; while (cond) { __builtin_amdgcn_s_sleep(1); \
    if ((++_sp & 255u) == 0u) { if (xb_ld(&(bar)[XB_TMO])) break; if (_sp > XB_SPIN_CAP) { atomicAdd(&(bar)[XB_TMO], 1u); break; } } } } while (0)
struct XcdBarrier { unsigned* bar; unsigned x; volatile LAS unsigned* st; int wave; };
__device__ __forceinline__ XcdBarrier xcd_barrier_post(unsigned* bar, volatile LAS unsigned* st, int wave) {
    XcdBarrier b; b.bar = bar; b.x = xb_xcc_id(); b.st = st; b.wave = wave;
    if (wave == 0 && lane_id() == 0) (void)xb_add(&bar[XB_XCNT(b.x)], 1u);
    return b;
}
__device__ __forceinline__ void xcd_barrier_complete(unsigned* bar, unsigned x, unsigned& nloc, unsigned& nx) {
    const unsigned G = gridDim.x * gridDim.y * gridDim.z;
    unsigned sum, cnt, mine, sp = 0u;
    for (;;) {
        sum = 0u; cnt = 0u; mine = 0u;
#pragma unroll
        for (unsigned j = 0; j < 16; ++j) { const unsigned c = xb_ld(&bar[XB_XCNT(j)]); sum += c; cnt += (c > 0u) ? 1u : 0u; mine = (j == x) ? c : mine; }
        if (sum == G) break;
        __builtin_amdgcn_s_sleep(1);
        if ((++sp & 255u) == 0u) { if (xb_ld(&bar[XB_TMO])) break; if (sp > XB_SPIN_CAP) { atomicAdd(&bar[XB_TMO], 1u); break; } }
    }
    nloc = mine > 0u ? mine : 1u; nx = cnt > 0u ? cnt : 1u;
}
__device__ __forceinline__ void xcd_barrier(const XcdBarrier& b) {
    asm volatile("s_waitcnt vmcnt(0)" ::: "memory");
    __syncthreads();
    if (b.wave == 0 && lane_id() == 0) {
        unsigned* bar = b.bar;
        __builtin_amdgcn_s_waitcnt(0);
        unsigned nloc = b.st[0], nx = b.st[1];
        if (nloc == 0u) { xcd_barrier_complete(bar, b.x, nloc, nx); b.st[0] = nloc; b.st[1] = nx; }
        const unsigned old = xb_add(&bar[XB_XSUB(b.x)], 1u);
        const unsigned gen = old / nloc;
        if (old + 1u == (gen + 1u) * nloc) {
            __builtin_amdgcn_fence(__ATOMIC_RELEASE, "agent");
            asm volatile("s_waitcnt vmcnt(0)" ::: "memory");
            const unsigned og = xb_add(&bar[XB_TOP], 1u);
            const unsigned tg = og / nx;
            if (og + 1u == (tg + 1u) * nx) xb_add(&bar[XB_TOPGEN], 1u);
            else XB_SPIN(xb_ld(&bar[XB_TOPGEN]) == tg, bar);
            __builtin_amdgcn_fence(__ATOMIC_ACQUIRE, "agent");
            xb_add(&bar[XB_XGEN(b.x)], 1u);
            asm volatile("s_waitcnt vmcnt(0)" ::: "memory");
        } else {
            XB_SPIN(xb_ld(&bar[XB_XGEN(b.x)]) == gen, bar);
            __builtin_amdgcn_fence(__ATOMIC_ACQUIRE, "agent");
            asm volatile("s_waitcnt vmcnt(0)" ::: "memory");
        }
    }
    __syncthreads();
}

namespace pg8 {
constexpr int BM = 256, BK = 64, HALF = 128, HTB = HALF * BK * 2, STAGE_BYTES = 8 * HTB, NXCD = 8, WGM = 8;
__host__ __device__ __forceinline__ int lds_byte(int r, int c) { const int st = (r >> 4) * 2 + (c >> 5), rr = r & 15, cc = c & 31, ob = rr * 64 + cc * 2; return st * 1024 + (ob ^ (((ob >> 9) & 1) << 5)); }
__host__ __device__ __forceinline__ void stage_rc(int b, int& R, int& C) { const int st = b / 1024, sb = b % 1024, swz = sb ^ (((sb >> 9) & 1) << 5); R = (st >> 1) * 16 + swz / 64; C = (st & 1) * 32 + (swz % 64) / 2; }
__host__ __device__ __forceinline__ int f8g(int rr) { return ((rr >> 2) ^ (rr >> 3)) & 1; }
__host__ __device__ __forceinline__ int lds_byte_f8(int r, int cb) { const int st = (r >> 4) * 2 + (cb >> 6), rr = r & 15; int ob = rr * 64 + (cb & 63); ob ^= ((ob >> 9) & 1) << 5; ob ^= f8g(rr) << 4; return st * 1024 + ob; }
__host__ __device__ __forceinline__ void stage_rc_f8(int b, int& R, int& C) { const int st = b / 1024, sb = b % 1024, rr = sb >> 6, sb1 = sb ^ (f8g(rr) << 4), sb2 = sb1 ^ (((sb1 >> 9) & 1) << 5); R = (st >> 1) * 16 + sb2 / 64; C = ((st & 1) * 64 + (sb2 % 64)) / 2; }
__host__ __device__ __forceinline__ int perm32(int rho) { const int n = rho >> 4, i = rho & 15; return 8 * (i >> 2) + 4 * n + (i & 3); }

struct Unit {
    const char* Bp;
    int arow0;
    int alim;
    int orow0;
    int pn;
    int e;
    int koff;
    int auxoff;
};

__device__ __forceinline__ bool static_tile(int L, int nM, int nN, int& pm, int& pn) {
    const int nwg = nM * nN; if (L >= nwg) return false;
    int wgid = L; { const int q = nwg / NXCD, r = nwg % NXCD, xcd = wgid % NXCD, off = wgid / NXCD; wgid = (xcd < r ? xcd * (q + 1) : r * (q + 1) + (xcd - r) * q) + off; }
    const int nig = WGM * nN, gid = wgid / nig, fm = gid * WGM, gsz = (nM - fm) < WGM ? (nM - fm) : WGM;
    pm = fm + ((wgid % nig) % gsz); pn = (wgid % nig) / gsz; return true;
}

template <bool FP8> struct Frag;
template <> struct Frag<false> { bf16x8 k[2]; };
template <> struct Frag<true> { v8i32 v; };
template <class Epi, class Sched, bool FP8 = false>
__device__ __forceinline__ void gemm_phase(const int wid, LAS unsigned char* lds, const char* Abase, const int ldab, const int Kb, const Sched& S, const Epi& E, const int ktiles = 0) {
    int lane_ = lane_id(); asm volatile("" : "+v"(lane_));
    const int lane = lane_, tid = wid * 64 + lane, wr = wid >> 2, wc = wid & 3, fr = lane & 15, fq = lane >> 4;
    const int nt = ktiles ? ktiles : Kb / 128;
    int Rr[2], Cc[2]; unsigned voffB[2];
#pragma unroll
    for (int i = 0; i < 2; ++i) { if constexpr (FP8) stage_rc_f8(tid * 16 + i * 8192, Rr[i], Cc[i]); else stage_rc(tid * 16 + i * 8192, Rr[i], Cc[i]); const int ii_ = Rr[i] & 15; const int Rb = Epi::PERM ? (64 * (Rr[i] >> 5) + 16 * (ii_ >> 2) + 4 * ((Rr[i] >> 4) & 1) + (ii_ & 3)) : Rr[i]; voffB[i] = (unsigned)(Rb * Kb + Cc[i] * 2); }
    const size_t kstep = (size_t)(BK * 2);
    const size_t hstepB = Epi::PERM ? (size_t)8 * Kb : (size_t)HALF * Kb;
    const unsigned ldsw = (unsigned)wid * 1024u;
    const int aoff = FP8 ? lds_byte_f8(wr * 64 + fr, fq * 32) : lds_byte(wr * 64 + fr, fq * 8), boff = FP8 ? lds_byte_f8(wc * 32 + fr, fq * 32) : lds_byte(wc * 32 + fr, fq * 8);
    const int aoff2 = aoff ^ 16, boff2 = boff ^ 16;
    unsigned la0 = (unsigned)(size_t)lds + aoff, la1 = (unsigned)(size_t)lds + aoff2, lb0 = (unsigned)(size_t)lds + 65536u + boff, lb1 = (unsigned)(size_t)lds + 65536u + boff2;
    asm volatile("" : "+v"(la0), "+v"(la1), "+v"(lb0), "+v"(lb1));
#define PG8_SA(b, h) (((b) * 2 + (h)) * HTB)
#define PG8_SB(b, h) ((4 + (b) * 2 + (h)) * HTB)
#define PG8_STAGE(bufoff, gbase, v0, v1) do { \
        __builtin_amdgcn_global_load_lds((const unsigned*)((const char*)(gbase) + (v0)), (LAS unsigned*)(lds + (bufoff) + ldsw), 16, 0, 0); \
        __builtin_amdgcn_global_load_lds((const unsigned*)((const char*)(gbase) + (v1)), (LAS unsigned*)(lds + (bufoff) + ldsw + 8192), 16, 0, 0); } while (0)
#define PG8_LDF(dst, base_, o1_, o2_) do { if constexpr (FP8) (dst).v = __builtin_shufflevector(*(const LAS v4i32*)(size_t)((o1_) + (unsigned)(base_)), *(const LAS v4i32*)(size_t)((o2_) + (unsigned)(base_)), 0, 1, 2, 3, 4, 5, 6, 7); \
        else { (dst).k[0] = *(const LAS bf16x8*)(size_t)((o1_) + (unsigned)(base_)); (dst).k[1] = *(const LAS bf16x8*)(size_t)((o1_) + (unsigned)(base_) + 1024u); } } while (0)
#define PG8_LDA(dst, b, h) do { _Pragma("unroll") for (int m = 0; m < 4; ++m) PG8_LDF(dst[m], PG8_SA(b, h) + m * 2048, la0, la1); } while (0)
#define PG8_LDB(dst, b, h) do { _Pragma("unroll") for (int n = 0; n < 2; ++n) PG8_LDF(dst[n], PG8_SB(b, h) - 65536 + n * 2048, lb0, lb1); } while (0)
#define PG8_MMA(ai, bj, At, Bt) do { __builtin_amdgcn_s_setprio(1); _Pragma("unroll") for (int m = 0; m < 4; ++m) _Pragma("unroll") for (int n = 0; n < 2; ++n) { \
        if constexpr (FP8) acc[ai][bj][m][n] = __builtin_amdgcn_mfma_scale_f32_16x16x128_f8f6f4(Bt[n].v, At[m].v, acc[ai][bj][m][n], 0, 0, 0, 0, 0, 0); \
        else { _Pragma("unroll") for (int k = 0; k < 2; ++k) acc[ai][bj][m][n] = __builtin_amdgcn_mfma_f32_16x16x32_bf16(Bt[n].k[k], At[m].k[k], acc[ai][bj][m][n], 0, 0, 0); } } \
        __builtin_amdgcn_s_setprio(0); } while (0)
#define PG8_WAIT_V(n) asm volatile("s_waitcnt vmcnt(" #n ")" ::: "memory")
#define PG8_WAIT_L(n) asm volatile("s_waitcnt lgkmcnt(" #n ")" ::: "memory")
#define PG8_BAR __builtin_amdgcn_s_barrier()
#define PG8_SCHED __builtin_amdgcn_sched_barrier(0)
#define PG8_AOFFS(dst, u) do { _Pragma("unroll") for (int h = 0; h < 2; ++h) _Pragma("unroll") for (int i = 0; i < 2; ++i) \
        dst[h][i] = (unsigned)(S.arow((u), h * HALF + Rr[i]) * ldab + Cc[i] * 2 + (u).koff); } while (0)
    Unit cur, nxt; int ui = 0;
    if (!S.next(0, cur)) return;
    constexpr int AUX_OFF = LDS_MISC + 2048;
    cur.auxoff = 0;
    if constexpr (Sched::AUX) __builtin_amdgcn_global_load_lds(S.aux_src(cur, wid, lane), (LAS unsigned*)(lds + AUX_OFF + wid * 256), 4, 0, 0);
    f32x4 acc[2][2][4][2];
#pragma unroll
    for (int a = 0; a < 2; ++a)
#pragma unroll
        for (int b = 0; b < 2; ++b)
#pragma unroll
            for (int m = 0; m < 4; ++m)
#pragma unroll
                for (int n = 0; n < 2; ++n) acc[a][b][m][n] = (f32x4){0.f, 0.f, 0.f, 0.f};
    Frag<FP8> At[4], B0[2], B1[2];
    unsigned aoC[2][2], aoN[2][2];
    PG8_AOFFS(aoC, cur);
    const char* cB = cur.Bp;
    PG8_STAGE(PG8_SB(0, 0), cB, voffB[0], voffB[1]); PG8_STAGE(PG8_SA(0, 0), Abase, aoC[0][0], aoC[0][1]);
    PG8_STAGE(PG8_SB(0, 1), cB + hstepB, voffB[0], voffB[1]); PG8_STAGE(PG8_SA(0, 1), Abase, aoC[1][0], aoC[1][1]);
    if (wr == 1) PG8_BAR;
    PG8_WAIT_V(4); PG8_BAR;
    PG8_STAGE(PG8_SB(1, 0), cB + kstep, voffB[0], voffB[1]); PG8_STAGE(PG8_SA(1, 0), Abase + kstep, aoC[0][0], aoC[0][1]);
    PG8_STAGE(PG8_SB(1, 1), cB + hstepB + kstep, voffB[0], voffB[1]);
    PG8_WAIT_V(6); PG8_BAR;
    for (;;) {
        const bool has_next = S.next(ui + 1, nxt);
        nxt.auxoff = ((ui + 1) % 3) * 2048;
        if constexpr (Sched::AUX) { if (has_next) __builtin_amdgcn_global_load_lds(S.aux_src(nxt, wid, lane), (LAS unsigned*)(lds + AUX_OFF + nxt.auxoff + wid * 256), 4, 0, 0); }
        if (has_next && !Sched::AUX) { PG8_AOFFS(aoN, nxt); }
        else {
#pragma unroll
            for (int h = 0; h < 2; ++h)
#pragma unroll
                for (int i = 0; i < 2; ++i) aoN[h][i] = aoC[h][i];
        }
        const char* nB = has_next ? nxt.Bp : cB;
#pragma clang loop unroll(disable)
        for (int t = 0; t < nt; t += 2) {
            const bool last = (t == nt - 2);
            if constexpr (Sched::AUX) { if (last && has_next) {
                _Pragma("unroll") for (int h = 0; h < 2; ++h) _Pragma("unroll") for (int i = 0; i < 2; ++i) { const int r = h * HALF + Rr[i]; const int row = (r < nxt.alim) ? ((const LAS int*)(lds + AUX_OFF + nxt.auxoff))[r] : 0;
                    aoN[h][i] = (unsigned)(row * ldab + Cc[i] * 2 + nxt.koff); } } }
            const char* a1 = Abase + (size_t)(t + 1) * kstep;
            const char* a2 = last ? Abase : Abase + (size_t)(t + 2) * kstep; const char* b2 = last ? nB : cB + (size_t)(t + 2) * kstep;
            const char* a3 = a2 + kstep; const char* b3 = b2 + kstep;
            const unsigned s00 = last ? aoN[0][0] : aoC[0][0], s01 = last ? aoN[0][1] : aoC[0][1], s10 = last ? aoN[1][0] : aoC[1][0], s11 = last ? aoN[1][1] : aoC[1][1];
            if constexpr (!FP8) {
            PG8_LDB(B0, 0, 0); PG8_SCHED; PG8_LDA(At, 0, 0); PG8_STAGE(PG8_SA(1, 1), a1, aoC[1][0], aoC[1][1]);
            PG8_WAIT_L(8); PG8_BAR; PG8_WAIT_L(0); PG8_MMA(0, 0, At, B0); PG8_BAR; PG8_SCHED;
            PG8_LDB(B1, 0, 1); PG8_STAGE(PG8_SB(0, 0), b2, voffB[0], voffB[1]);
            PG8_BAR; PG8_WAIT_L(0); PG8_MMA(0, 1, At, B1); PG8_BAR;
            PG8_LDA(At, 0, 1); PG8_STAGE(PG8_SA(0, 0), a2, s00, s01);
            PG8_BAR; PG8_WAIT_L(0); PG8_MMA(1, 0, At, B0); PG8_BAR; PG8_SCHED;
            PG8_STAGE(PG8_SB(0, 1), b2 + hstepB, voffB[0], voffB[1]);
            PG8_WAIT_V(6); PG8_BAR; PG8_MMA(1, 1, At, B1); PG8_BAR;
            PG8_LDB(B0, 1, 0); PG8_SCHED; PG8_LDA(At, 1, 0); PG8_STAGE(PG8_SA(0, 1), a2, s10, s11);
            PG8_WAIT_L(8); PG8_BAR; PG8_WAIT_L(0); PG8_MMA(0, 0, At, B0); PG8_BAR; PG8_SCHED;
            PG8_LDB(B1, 1, 1); PG8_STAGE(PG8_SB(1, 0), b3, voffB[0], voffB[1]);
            PG8_BAR; PG8_WAIT_L(0); PG8_MMA(0, 1, At, B1); PG8_BAR;
            PG8_LDA(At, 1, 1); PG8_STAGE(PG8_SA(1, 0), a3, s00, s01);
            PG8_BAR; PG8_WAIT_L(0); PG8_MMA(1, 0, At, B0); PG8_BAR; PG8_SCHED;
            PG8_STAGE(PG8_SB(1, 1), b3 + hstepB, voffB[0], voffB[1]);
            PG8_WAIT_V(6); PG8_BAR; PG8_MMA(1, 1, At, B1); PG8_BAR;
            } else {
            PG8_LDB(B0, 0, 0); PG8_SCHED; PG8_LDA(At, 0, 0); PG8_STAGE(PG8_SA(1, 1), a1, aoC[1][0], aoC[1][1]);
            PG8_WAIT_L(8); PG8_BAR; PG8_WAIT_L(0); PG8_MMA(0, 0, At, B0); PG8_BAR; PG8_SCHED;
            PG8_LDB(B0, 0, 1);
            PG8_BAR; PG8_WAIT_L(0); PG8_MMA(0, 1, At, B0); PG8_BAR; PG8_SCHED;
            PG8_LDB(B0, 0, 0); PG8_SCHED; PG8_LDA(At, 0, 1); PG8_STAGE(PG8_SA(0, 0), a2, s00, s01);
            PG8_WAIT_L(8); PG8_BAR; PG8_WAIT_L(0); PG8_MMA(1, 0, At, B0); PG8_BAR; PG8_SCHED;
            PG8_LDB(B0, 0, 1); PG8_STAGE(PG8_SB(0, 0), b2, voffB[0], voffB[1]);
            PG8_WAIT_V(4); PG8_WAIT_L(0); PG8_BAR; PG8_MMA(1, 1, At, B0); PG8_BAR; PG8_SCHED;
            PG8_LDB(B0, 1, 0); PG8_SCHED; PG8_LDA(At, 1, 0); PG8_STAGE(PG8_SA(0, 1), a2, s10, s11); PG8_STAGE(PG8_SB(0, 1), b2 + hstepB, voffB[0], voffB[1]);
            PG8_WAIT_L(8); PG8_BAR; PG8_WAIT_L(0); PG8_MMA(0, 0, At, B0); PG8_BAR; PG8_SCHED;
            PG8_LDB(B0, 1, 1);
            PG8_BAR; PG8_WAIT_L(0); PG8_MMA(0, 1, At, B0); PG8_BAR; PG8_SCHED;
            PG8_LDB(B0, 1, 0); PG8_SCHED; PG8_LDA(At, 1, 1); PG8_STAGE(PG8_SA(1, 0), a3, s00, s01);
            PG8_WAIT_L(8); PG8_BAR; PG8_WAIT_L(0); PG8_MMA(1, 0, At, B0); PG8_BAR; PG8_SCHED;
            PG8_LDB(B0, 1, 1); PG8_STAGE(PG8_SB(1, 0), b3, voffB[0], voffB[1]);
            PG8_WAIT_V(4); PG8_WAIT_L(0); PG8_BAR; PG8_MMA(1, 1, At, B0); PG8_BAR; PG8_SCHED;
            PG8_STAGE(PG8_SB(1, 1), b3 + hstepB, voffB[0], voffB[1]);
            }
        }
        if (wr == 0) PG8_BAR;
        E(acc, cur, wr, wc, fr, fq);
        if (!has_next) break;
        if (wr == 1) PG8_BAR;
#pragma unroll
        for (int a = 0; a < 2; ++a)
#pragma unroll
            for (int b = 0; b < 2; ++b)
#pragma unroll
                for (int m = 0; m < 4; ++m)
#pragma unroll
                    for (int n = 0; n < 2; ++n) acc[a][b][m][n] = (f32x4){0.f, 0.f, 0.f, 0.f};
        cur = nxt; cB = nB; ++ui;
#pragma unroll
        for (int h = 0; h < 2; ++h)
#pragma unroll
            for (int i = 0; i < 2; ++i) aoC[h][i] = aoN[h][i];
    }
    PG8_WAIT_V(0);
    PG8_BAR;
#undef PG8_SA
#undef PG8_SB
#undef PG8_STAGE
#undef PG8_LDA
#undef PG8_LDF
#undef PG8_LDB
#undef PG8_MMA
#undef PG8_WAIT_V
#undef PG8_WAIT_L
#undef PG8_BAR
#undef PG8_SCHED
#undef PG8_AOFFS
}
}
using pg8::Unit;

struct DenseSched {
    static constexpr bool AUX = false;
    const char* Bt; size_t tile_bytes; int nM, nN, G, c, lat, extra;
    __device__ __forceinline__ bool next(int i, Unit& u) const {
        const int L = i * G + c; int pm, pn;
        if (pg8::static_tile(L, nM, nN, pm, pn)) { if (lat) pm = (pm >> 3) * 9 + 1 + (pm & 7); }
        else { const int j = L - nM * nN; if (j < 0 || j >= extra) return false; pm = (j >> 2) * 9; pn = 8 + (j & 3); }
        u.Bp = Bt + (size_t)pn * tile_bytes; u.arow0 = pm * 256; u.alim = 256; u.orow0 = pm * 256; u.pn = pn; u.e = -1; u.koff = 0; return true;
    }
    __device__ __forceinline__ int arow(const Unit& u, int r) const { return u.arow0 + r; }
};
struct PanelSched {
    static constexpr bool AUX = false;
    const char* Bt; size_t tile_bytes; int nM, nN, G, c, lat, pm0;
    __device__ __forceinline__ bool next(int i, Unit& u) const {
        const int L = i * G + c; if (L >= nM * nN) return false;
        int pm = L / nN; const int pn = L - pm * nN; pm += pm0; if (lat) pm = (pm >> 3) * 9 + 1 + (pm & 7);
        u.Bp = Bt + (size_t)pn * tile_bytes; u.arow0 = pm * 256; u.alim = 256; u.orow0 = pm * 256; u.pn = pn; u.e = -1; u.koff = 0; return true;
    }
    __device__ __forceinline__ int arow(const Unit& u, int r) const { return u.arow0 + r; }
};
struct RouterSched {
    static constexpr bool AUX = false;
    const char* Bt; int nM, G, c, lat;
    __device__ __forceinline__ bool next(int i, Unit& u) const {
        const int L = i * G + c; if (L >= nM * 4) return false;
        int pm = L >> 2; const int ks = L & 3; if (lat) pm = (pm >> 3) * 9 + 1 + (pm & 7);
        u.koff = ks * 1024; u.Bp = Bt + u.koff; u.arow0 = pm * 256; u.alim = 256; u.orow0 = pm * 256; u.pn = ks; u.e = -1; return true;
    }
    __device__ __forceinline__ int arow(const Unit& u, int r) const { return u.arow0 + r; }
};
template <bool GATHER> struct MoeSched {
    static constexpr bool AUX = GATHER;
    const float* wlist_;
    __device__ __forceinline__ const unsigned* aux_src(const Unit& u, int wid, int lane) const { const int r = (wid & 3) * 64 + lane; return (wid < 4) ? (const unsigned*)(list + u.arow0 + r) : (const unsigned*)(wlist_ + u.arow0 + r); }
    const LAS int* ublk; const int* cnt; const int* list; const char* Bt; size_t e_stride; const char* Bts; size_t tile_bytes; int npn, nshared, lat, G, c;
    __device__ __forceinline__ bool next(int i, Unit& u) const {
        const int L = i * G + c; const int tot = ublk[NEXP]; if (L >= (tot + nshared) * npn) return false;
        const int mbg = L / npn, pn = L - mbg * npn;
        if (mbg < tot) { const int e = ((const LAS unsigned short*)(ublk + 128))[mbg]  , mb = mbg - ublk[e]; u.e = e; u.Bp = Bt + (size_t)e * e_stride + (size_t)pn * tile_bytes;
            u.arow0 = GATHER ? e * CAP + mb * 256 : mbg * 256; const int rem = cnt[e * CNT_STRIDE] - mb * 256; u.alim = rem < 256 ? rem : 256; }
        else { const int j = mbg - tot; u.e = -1; u.Bp = Bts + (size_t)pn * tile_bytes; const int pm = lat ? (j >> 3) * 9 + 1 + (j & 7) : j; u.arow0 = GATHER ? IDENT_OFF + pm * 256 : mbg * 256; u.alim = 256; }
        u.orow0 = mbg * 256; u.pn = pn; u.koff = 0; return true;
    }
    __device__ __forceinline__ int arow(const Unit& u, int r) const {
        if (GATHER) return (r < u.alim) ? list[u.arow0 + r] : 0;
        return u.arow0 + r;
    }
};

typedef f32x4 acc_t[2][2][4][2];
__device__ __forceinline__ unsigned pack4_fp8(float a, float b, float c, float d) {
    a = __builtin_amdgcn_fmed3f(a, -440.f, 440.f); b = __builtin_amdgcn_fmed3f(b, -440.f, 440.f); c = __builtin_amdgcn_fmed3f(c, -440.f, 440.f); d = __builtin_amdgcn_fmed3f(d, -440.f, 440.f);
    int w = __builtin_amdgcn_cvt_pk_fp8_f32(a, b, 0, false); w = __builtin_amdgcn_cvt_pk_fp8_f32(c, d, w, true); return (unsigned)w;
}

__device__ __forceinline__ u32x4 pack8(f32x4 v0, f32x4 v1) { u32x4 w; w.x = cvt_pk_bf16(v0[0], v0[1]); w.y = cvt_pk_bf16(v0[2], v0[3]); w.z = cvt_pk_bf16(v1[0], v1[1]); w.w = cvt_pk_bf16(v1[2], v1[3]); return w; }

struct EpiDown {
    static constexpr bool PERM = true;
    unsigned char* O; float* ssqp;
    __device__ __forceinline__ void operator()(const acc_t& acc, const Unit& u, int wr, int wc, int fr, int fq) const {
        const int row0 = u.orow0 + wr * 64 + fr, col0 = u.pn * 256 + wc * 64 + 16 * fq;
#pragma unroll
        for (int ai = 0; ai < 2; ++ai)
#pragma unroll
            for (int m = 0; m < 4; ++m) { const int row = row0 + ai * 128 + m * 16; float s = 0.f; u32x4 q;
#pragma unroll
                for (int bj = 0; bj < 2; ++bj) { const f32x4 v0 = acc[ai][bj][m][0] * (1.f / W1_SCALE), v1 = acc[ai][bj][m][1] * (1.f / W1_SCALE);
                    s += (v0[0] * v0[0] + v0[1] * v0[1]) + (v0[2] * v0[2] + v0[3] * v0[3]) + (v1[0] * v1[0] + v1[1] * v1[1]) + (v1[2] * v1[2] + v1[3] * v1[3]);
                    const unsigned p0 = pack4_fp8(v0[0], v0[1], v0[2], v0[3]), p1 = pack4_fp8(v1[0], v1[1], v1[2], v1[3]);
                    if (bj == 0) { q.x = p0; q.y = p1; } else { q.z = p0; q.w = p1; } }
                *(u32x4*)(O + (size_t)row * 1536 + col0) = q;
                s += __shfl_xor(s, 16); s += __shfl_xor(s, 32);
                if (fq == 0) ssqp[(size_t)row * 24 + u.pn * 4 + wc] = s; }
    }
};
struct EpiScaleBf16 {
    static constexpr bool PERM = true;
    bf16* O; int ldo; const float* ssqp; int p0, np; float invn; float ds;
    __device__ __forceinline__ void operator()(const acc_t& acc, const Unit& u, int wr, int wc, int fr, int fq) const {
        const int row0 = u.orow0 + wr * 64 + fr, col0 = u.pn * 256 + wc * 64 + 16 * fq;
#pragma unroll
        for (int ai = 0; ai < 2; ++ai)
#pragma unroll
            for (int m = 0; m < 4; ++m) { const int row = row0 + ai * 128 + m * 16;
                float rs = invn;
                if (ssqp) { const float* sp = ssqp + (size_t)row * 24 + p0; float t = 0.f;
                    for (int i = 0; i < np; ++i) { const f32x4 q = *(const f32x4*)(sp + 4 * i); t += (q[0] + q[1]) + (q[2] + q[3]); }
                    rs = __builtin_amdgcn_rsqf(t * invn + EPS) * ds; }
#pragma unroll
                for (int bj = 0; bj < 2; ++bj) *(u32x4*)(O + (size_t)row * ldo + col0 + bj * 8) = pack8(acc[ai][bj][m][0] * rs, acc[ai][bj][m][1] * rs); }
    }
};
struct EpiKV {
    static constexpr bool PERM = true;
    bf16* KV; unsigned char* KF; const unsigned char* down; const float* ssqp; const float* gk; LAS unsigned char* lds;
    __device__ __forceinline__ float rskv_of(int row) const { const float* sp = ssqp + (size_t)row * 24 + 12; const f32x4 q0 = *(const f32x4*)sp, q1 = *(const f32x4*)(sp + 4);
        return __builtin_amdgcn_rsqf((((q0[0] + q0[1]) + (q0[2] + q0[3])) + ((q1[0] + q1[1]) + (q1[2] + q1[3]))) * (1.f / 512.f) + EPS) * (1.f / W2_SCALE); }
    __device__ __forceinline__ void operator()(const acc_t& acc, const Unit& u, int wr, int wc, int fr, int fq) const {
        const int h = u.pn, r0 = wr * 64 + fr, pp = (u.orow0 >> 8) % 9;
        LAS float* xch = (LAS float*)(lds + LDS_MISC + 2048);
        if (wc < 2) {
#pragma unroll
            for (int ai = 0; ai < 2; ++ai)
#pragma unroll
                for (int m = 0; m < 4; ++m) { const float rskv = rskv_of(u.orow0 + r0 + ai * 128 + m * 16); float ss = 0.f;
#pragma unroll
                    for (int bj = 0; bj < 2; ++bj)
#pragma unroll
                        for (int n = 0; n < 2; ++n) { const f32x4 v = acc[ai][bj][m][n] * rskv; ss += (v[0] * v[0] + v[1] * v[1]) + (v[2] * v[2] + v[3] * v[3]); }
                    ss += __shfl_xor(ss, 16); ss += __shfl_xor(ss, 32);
                    if (fq == 0) xch[(wr * 2 + wc) * 128 + ai * 64 + m * 16 + fr] = ss; }
        }
        asm volatile("s_waitcnt lgkmcnt(0)" ::: "memory"); __builtin_amdgcn_s_barrier(); asm volatile("" ::: "memory");
        if (wc >= 2) {
            const int col0 = h * 256 + 128 + (wc - 2) * 64 + 16 * fq;
#pragma unroll
            for (int ai = 0; ai < 2; ++ai)
#pragma unroll
                for (int m = 0; m < 4; ++m) { const int row = u.orow0 + r0 + ai * 128 + m * 16; const float rs = rskv_of(row);
#pragma unroll
                    for (int bj = 0; bj < 2; ++bj) *(u32x4*)(KV + (size_t)row * 4096 + col0 + bj * 8) = pack8(acc[ai][bj][m][0] * rs, acc[ai][bj][m][1] * rs);
                    asm volatile("" ::: "memory"); }
        } else {
            const int c0 = wc * 64 + 16 * fq;
            const int rc = 32 * wc + 4 * fq;
#pragma unroll
            for (int ai = 0; ai < 2; ++ai)
#pragma unroll
                for (int m = 0; m < 4; ++m) { const int lr = ai * 64 + m * 16 + fr, row = u.orow0 + wr * 64 + ai * 128 + m * 16 + fr; const float rs = rskv_of(row);
                    const float ss = xch[(wr * 2) * 128 + lr] + xch[(wr * 2 + 1) * 128 + lr] + ssqp[(size_t)row * 24 + 20];
                    const float rsk = __builtin_amdgcn_rsqf(ss * (1.f / 192.f) + EPS), sc = rs * rsk;
                    u32x4 q8;
                    { const f32x4 v0 = acc[ai][0][m][0] * sc * *(const f32x4*)(gk + c0), v1 = acc[ai][0][m][1] * sc * *(const f32x4*)(gk + c0 + 4); q8.x = pack4_fp8(v0[0], v0[1], v0[2], v0[3]); q8.y = pack4_fp8(v1[0], v1[1], v1[2], v1[3]); }
                    { const f32x4 v0 = acc[ai][1][m][0] * sc * *(const f32x4*)(gk + c0 + 8), v1 = acc[ai][1][m][1] * sc * *(const f32x4*)(gk + c0 + 12); q8.z = pack4_fp8(v0[0], v0[1], v0[2], v0[3]); q8.w = pack4_fp8(v1[0], v1[1], v1[2], v1[3]); }
                    unsigned char* kp = KF + (size_t)row * 3072 + h * 192; *(u32x4*)(kp + c0) = q8;
                    const unsigned char* dp = down + (size_t)row * 1536 + 1280 + rc; const unsigned wa = *(const unsigned*)dp, wb = *(const unsigned*)(dp + 16);
                    const f32x4 ga = *(const f32x4*)(gk + 128 + rc), gb = *(const f32x4*)(gk + 128 + rc + 16);
                    const f32x2 a0 = __builtin_amdgcn_cvt_pk_f32_fp8((int)wa, false), a1 = __builtin_amdgcn_cvt_pk_f32_fp8((int)wa, true), b0 = __builtin_amdgcn_cvt_pk_f32_fp8((int)wb, false), b1 = __builtin_amdgcn_cvt_pk_f32_fp8((int)wb, true);
                    float ya[4] = {a0[0] * rsk * ga[0], a0[1] * rsk * ga[1], a1[0] * rsk * ga[2], a1[1] * rsk * ga[3]}, yb[4] = {b0[0] * rsk * gb[0], b0[1] * rsk * gb[1], b1[0] * rsk * gb[2], b1[1] * rsk * gb[3]};
                    if (pp != 0) { const int t = (pp - 1) * 256 + wr * 64 + ai * 128 + m * 16 + fr; const float pos = wc ? (float)(t & 63) : (float)(t >> 6);
#pragma unroll
                        for (int j = 0; j < 4; ++j) { const float fr_ = __builtin_amdgcn_exp2f(-(float)(4 * fq + j) * (1.f / 16.f) * 13.287712379549449f), ang = pos * fr_, cs = __cosf(ang), sn = __sinf(ang);
                            const float a = ya[j], b = yb[j]; ya[j] = a * cs - b * sn; yb[j] = b * cs + a * sn; } }
                    *(unsigned*)(kp + 128 + rc) = pack4_fp8(ya[0], ya[1], ya[2], ya[3]); *(unsigned*)(kp + 128 + rc + 16) = pack4_fp8(yb[0], yb[1], yb[2], yb[3]);
                    asm volatile("" ::: "memory"); }
        }
    }
};
struct EpiQKV1 {
    static constexpr bool PERM = true;
    bf16* RAW; unsigned char* KF; const float* gk; LAS unsigned char* lds;
    __device__ __forceinline__ void operator()(const acc_t& acc, const Unit& u, int wr, int wc, int fr, int fq) const {
        const int r0 = wr * 64 + fr; constexpr float DS = 1.f / W1_SCALE;
        if (u.pn != 8 && u.pn != 9) {
            const int col0 = u.pn * 256 + wc * 64 + 16 * fq;
#pragma unroll
            for (int ai = 0; ai < 2; ++ai)
#pragma unroll
                for (int m = 0; m < 4; ++m) { const int row = u.orow0 + r0 + ai * 128 + m * 16;
#pragma unroll
                    for (int bj = 0; bj < 2; ++bj) *(u32x4*)(RAW + (size_t)row * 3072 + col0 + bj * 8) = pack8(acc[ai][bj][m][0] * DS, acc[ai][bj][m][1] * DS); }
            return; }
        const int pp = (u.orow0 >> 8) % 9, hsel = wc >> 1, wl = wc & 1;
        LAS float* xch = (LAS float*)(lds + LDS_MISC + 2048);
#pragma unroll
        for (int ai = 0; ai < 2; ++ai)
#pragma unroll
            for (int m = 0; m < 4; ++m) { float ss = 0.f;
#pragma unroll
                for (int bj = 0; bj < 2; ++bj)
#pragma unroll
                    for (int n = 0; n < 2; ++n) { const f32x4 v = acc[ai][bj][m][n] * DS; ss += (v[0] * v[0] + v[1] * v[1]) + (v[2] * v[2] + v[3] * v[3]); }
                ss += __shfl_xor(ss, 16); ss += __shfl_xor(ss, 32);
                if (fq == 0) xch[(wr * 4 + wc) * 128 + ai * 64 + m * 16 + fr] = ss; }
        asm volatile("s_waitcnt lgkmcnt(0)" ::: "memory"); __builtin_amdgcn_s_barrier(); asm volatile("" ::: "memory");
        const int g = 2 * (u.pn - 8) + hsel, d0 = 64 * wl + 16 * fq;
        const bool second = (fq >> 1) != 0;
#pragma unroll
        for (int ai = 0; ai < 2; ++ai)
#pragma unroll
            for (int m = 0; m < 4; ++m) { const int lr = ai * 64 + m * 16 + fr, row = u.orow0 + wr * 64 + ai * 128 + m * 16 + fr;
                const float ss = xch[(wr * 4 + (wc & 2)) * 128 + lr] + xch[(wr * 4 + (wc | 1)) * 128 + lr];
                const float sc = __builtin_amdgcn_rsqf(ss * (1.f / 128.f) + EPS) * DS;
                float y[16];
#pragma unroll
                for (int bj = 0; bj < 2; ++bj)
#pragma unroll
                    for (int n = 0; n < 2; ++n) { const f32x4 gg = *(const f32x4*)(gk + d0 + 8 * bj + 4 * n); const f32x4 v = acc[ai][bj][m][n] * sc * gg;
                        y[8 * bj + 4 * n] = v[0]; y[8 * bj + 4 * n + 1] = v[1]; y[8 * bj + 4 * n + 2] = v[2]; y[8 * bj + 4 * n + 3] = v[3]; }
                if (pp != 0) { const int t = (pp - 1) * 256 + wr * 64 + ai * 128 + m * 16 + fr; const float pos = wl ? (float)(t & 63) : (float)(t >> 6);
#pragma unroll
                    for (int i = 0; i < 16; ++i) { const float oth = __shfl_xor(y[i], 32);
                        const float fr_ = __builtin_amdgcn_exp2f(-(float)(16 * (fq & 1) + i) * (1.f / 32.f) * 13.287712379549449f), ang = pos * fr_, cs = __cosf(ang), sn = __sinf(ang);
                        y[i] = second ? (y[i] * cs + oth * sn) : (y[i] * cs - oth * sn); } }
                u32x4 q8; q8.x = pack4_fp8(y[0], y[1], y[2], y[3]); q8.y = pack4_fp8(y[4], y[5], y[6], y[7]); q8.z = pack4_fp8(y[8], y[9], y[10], y[11]); q8.w = pack4_fp8(y[12], y[13], y[14], y[15]);
                *(u32x4*)(KF + (size_t)row * 512 + g * 128 + d0) = q8;
                asm volatile("" ::: "memory"); }
    }
};
struct EpiResid {
    static constexpr bool PERM = false;
    const float* x; const float* ctx; const bf16* hin; bf16* hout; const float* mod; int gate_off; int layer0; float ds;
    __device__ __forceinline__ void operator()(const acc_t& acc, const Unit& u, int wr, int wc, int fr, int fq) const {
        const int pm = u.orow0 >> 8, b = pm / 9, pp = pm - b * 9;
        const float* gate = mod + (size_t)(pp == 0 ? 8 : b) * NMOD + gate_off;
        const float* src = (pp == 0) ? ctx + (size_t)b * CTXL * DM : x + ((size_t)b * SEQ + (size_t)(pp - 1) * 256) * DM;
        const int r0 = wr * 64 + fr, col0 = u.pn * 256 + wc * 32 + 4 * fq;
#pragma unroll
        for (int ai = 0; ai < 2; ++ai)
#pragma unroll
            for (int m = 0; m < 4; ++m) { const int r = r0 + ai * 128 + m * 16; const size_t ro = (size_t)(u.orow0 + r) * DM + col0;
#pragma unroll
                for (int bj = 0; bj < 2; ++bj)
#pragma unroll
                    for (int n = 0; n < 2; ++n) { const int co = bj * 128 + n * 16; f32x4 hv;
                        if (layer0) hv = *(const f32x4*)(src + (size_t)r * DM + col0 + co);
                        else { const u32x2 w = *(const u32x2*)(hin + ro + co); hv = (f32x4){bf_lo(w.x), bf_hi(w.x), bf_lo(w.y), bf_hi(w.y)}; }
                        const f32x4 o = hv + *(const f32x4*)(gate + col0 + co) * (acc[ai][bj][m][n] * ds);
                        u32x2 q; q.x = cvt_pk_bf16(o[0], o[1]); q.y = cvt_pk_bf16(o[2], o[3]); *(u32x2*)(hout + ro + co) = q; }
                asm volatile("" ::: "memory"); }
    }
};
struct EpiRouter {
    static constexpr bool PERM = false;
    float* lp;
    __device__ __forceinline__ void operator()(const acc_t& acc, const Unit& u, int wr, int wc, int fr, int fq) const {
        if (wc >= 2) return;
        const int row0 = u.orow0 + wr * 64 + fr, col0 = wc * 32 + 4 * fq; float* base = lp + (size_t)u.pn * MT * 64;
#pragma unroll
        for (int ai = 0; ai < 2; ++ai)
#pragma unroll
            for (int m = 0; m < 4; ++m) { float* rp = base + (size_t)(row0 + ai * 128 + m * 16) * 64 + col0;
#pragma unroll
                for (int n = 0; n < 2; ++n) *(f32x4*)(rp + n * 16) = acc[ai][0][m][n] + acc[ai][1][m][n]; }
    }
};
__device__ __forceinline__ float silu_mul(float g, float uu) { return g * __builtin_amdgcn_rcpf(1.f + __builtin_amdgcn_exp2f(-1.4426950408889634f * g)) * uu; }
struct EpiAct {
    static constexpr bool PERM = true;
    unsigned char* act; LAS unsigned char* lds; unsigned char* acts;
    __device__ __forceinline__ void operator()(const acc_t& acc, const Unit& u, int wr, int wc, int fr, int fq) const {
        const int r0 = wr * 64 + fr, col0 = u.pn * 128 + wc * 32 + 8 * fq; const bool sh = u.e < 0;
        unsigned char* const ob = sh ? acts + (size_t)(u.arow0 - IDENT_OFF) * DEXP : act + (size_t)u.orow0 * DEXP;
        const LAS float* wp = (const LAS float*)(lds + LDS_MISC + 2048 + u.auxoff) + 256;
        constexpr float IG = 1.f / W1_SCALE, IU = ACT_SCALE_R / W1_SCALE;
#pragma unroll
        for (int ai = 0; ai < 2; ++ai)
#pragma unroll
            for (int m = 0; m < 4; ++m) { const int r = r0 + ai * 128 + m * 16; const float wu = wp[r] * IU; float v[8];
#pragma unroll
                for (int j = 0; j < 4; ++j) { v[j] = silu_mul(acc[ai][0][m][0][j] * IG, acc[ai][1][m][0][j] * wu); v[4 + j] = silu_mul(acc[ai][0][m][1][j] * IG, acc[ai][1][m][1][j] * wu); }
                u32x2 w; w.x = pack4_fp8(v[0], v[1], v[2], v[3]); w.y = pack4_fp8(v[4], v[5], v[6], v[7]);
                *(u32x2*)(ob + (size_t)r * DEXP + col0) = w; }
    }
};
struct EpiY {
    static constexpr bool PERM = true;
    unsigned char* Y; float DS;
    __device__ __forceinline__ void operator()(const acc_t& acc, const Unit& u, int wr, int wc, int fr, int fq) const {
        const int r0 = wr * 64 + fr, col0 = u.pn * 256 + wc * 64 + 16 * fq;
#pragma unroll
        for (int ai = 0; ai < 2; ++ai)
#pragma unroll
            for (int m = 0; m < 4; ++m) { const int r = r0 + ai * 128 + m * 16; u32x4 q;
                { const f32x4 v0 = acc[ai][0][m][0] * DS, v1 = acc[ai][0][m][1] * DS; q.x = pack4_fp8(v0[0], v0[1], v0[2], v0[3]); q.y = pack4_fp8(v1[0], v1[1], v1[2], v1[3]); }
                { const f32x4 v0 = acc[ai][1][m][0] * DS, v1 = acc[ai][1][m][1] * DS; q.z = pack4_fp8(v0[0], v0[1], v0[2], v0[3]); q.w = pack4_fp8(v1[0], v1[1], v1[2], v1[3]); }
                *(u32x4*)(Y + (size_t)(u.orow0 + r) * DM + col0) = q; }
    }
};
struct EpiActS {
    static constexpr bool PERM = true;
    unsigned char* act;
    __device__ __forceinline__ void operator()(const acc_t& acc, const Unit& u, int wr, int wc, int fr, int fq) const {
        const int row0 = u.orow0 + wr * 64 + fr, col0 = u.pn * 128 + wc * 32 + 8 * fq;
        constexpr float IG = 1.f / W1_SCALE, IU = ACT_SCALE / W1_SCALE;
#pragma unroll
        for (int ai = 0; ai < 2; ++ai)
#pragma unroll
            for (int m = 0; m < 4; ++m) { float v[8];
#pragma unroll
                for (int j = 0; j < 4; ++j) { v[j] = silu_mul(acc[ai][0][m][0][j] * IG, acc[ai][1][m][0][j] * IU); v[4 + j] = silu_mul(acc[ai][0][m][1][j] * IG, acc[ai][1][m][1][j] * IU); }
                u32x2 w; w.x = pack4_fp8(v[0], v[1], v[2], v[3]); w.y = pack4_fp8(v[4], v[5], v[6], v[7]);
                *(u32x2*)(act + (size_t)(row0 + ai * 128 + m * 16) * DEXP + col0) = w; }
    }
};

namespace att {
constexpr int NW = 8, QBLK = 32;
#define SBAR() __builtin_amdgcn_sched_barrier(0)
__device__ __forceinline__ int crow(int r, int hi) { return (r & 3) + 8 * (r >> 2) + 4 * hi; }
template <int DQK> __device__ __forceinline__ int kswz(int row, int colB) {
    if constexpr (DQK == 128) return row * 256 + (colB ^ ((row & 15) << 4));
    else return row * 384 + (colB ^ (((row >> 1) & 7) << 4));
}
constexpr int OPITCH = 272;
template <int DQK, int KVB> constexpr size_t shm_attn() { return 2 * (size_t)KVB * 128 * 2 + 2 * (size_t)KVB * DQK * 2 + NW * 64 * 4 + NW * 32 * OPITCH; }

template <int NP> __device__ __forceinline__ void partialSM(f32x16& p0, f32x16& p1, float& m_reg, float& mn, float& alpha, const float C, const float thr) {
  float pmax = p0[0]; for (int r = 1; r < 16; ++r) pmax = fmaxf(pmax, p0[r]);
  if constexpr (NP == 2) { for (int r = 0; r < 16; ++r) pmax = fmaxf(pmax, p1[r]); }
  { auto rr = __builtin_amdgcn_permlane32_swap(__float_as_uint(pmax), __float_as_uint(pmax), false, false);
    pmax = fmaxf(__uint_as_float(rr[0]), __uint_as_float(rr[1])); }
  if (__builtin_expect(__all(pmax - m_reg <= thr), 1)) { mn = m_reg; alpha = 1.f; }
  else { mn = fmaxf(m_reg, pmax); alpha = __builtin_amdgcn_exp2f((m_reg - mn) * C); m_reg = mn; }
  float mnC = -mn * C;
  for (int r = 0; r < 16; ++r) p0[r] = fmaf(p0[r], C, mnC);
  if constexpr (NP == 2) { for (int r = 0; r < 16; ++r) p1[r] = fmaf(p1[r], C, mnC); for (int r = 0; r < 16; ++r) p0[r] = __builtin_amdgcn_exp2f(p0[r]); }
  else { for (int r = 0; r < 8; ++r) p0[r] = __builtin_amdgcn_exp2f(p0[r]); }
}
template <int NP> __device__ __forceinline__ void finishSM(f32x16& p0, f32x16& p1, float alpha, float& l_reg, bf16x8& pa0, bf16x8& pa1, bf16x8& pa2, bf16x8& pa3) {
  if constexpr (NP == 2) { for (int r = 0; r < 16; ++r) p1[r] = __builtin_amdgcn_exp2f(p1[r]); } else { for (int r = 8; r < 16; ++r) p0[r] = __builtin_amdgcn_exp2f(p0[r]); }
  float ps = 0; for (int r = 0; r < 16; ++r) ps += p0[r];
  if constexpr (NP == 2) { for (int r = 0; r < 16; ++r) ps += p1[r]; }
  { auto rr = __builtin_amdgcn_permlane32_swap(__float_as_uint(ps), __float_as_uint(ps), false, false);
    ps = __uint_as_float(rr[0]) + __uint_as_float(rr[1]); }
  l_reg = l_reg * alpha + ps;
#define PK4(P, BASE, OUT) do { unsigned a0 = cvt_pk_bf16(P[BASE + 0], P[BASE + 1]), a1 = cvt_pk_bf16(P[BASE + 2], P[BASE + 3]);   \
    unsigned b0 = cvt_pk_bf16(P[BASE + 4], P[BASE + 5]), b1 = cvt_pk_bf16(P[BASE + 6], P[BASE + 7]);                              \
    auto r0 = __builtin_amdgcn_permlane32_swap(a0, b0, false, false); auto r1 = __builtin_amdgcn_permlane32_swap(a1, b1, false, false); \
    u32x4 w = {r0[0], r1[0], r0[1], r1[1]}; OUT = *reinterpret_cast<bf16x8*>(&w); } while (0)
  PK4(p0, 0, pa0); PK4(p0, 8, pa1);
  if constexpr (NP == 2) { PK4(p1, 0, pa2); PK4(p1, 8, pa3); }
#undef PK4
}
template <int DQK, int NP> __device__ __forceinline__ void qkt(f32x16& p0, f32x16& p1, const char* Ks, const bf16x8* qr, int r32, int hi) {
  p0 = f32x16{}; if constexpr (NP == 2) p1 = f32x16{};
  for (int d0 = 0; d0 < DQK / 16; ++d0) { int cb = (d0 * 16 + hi * 8) * 2;
    bf16x8 b0 = *reinterpret_cast<const bf16x8*>(Ks + kswz<DQK>(r32, cb));
    p0 = __builtin_amdgcn_mfma_f32_32x32x16_bf16(b0, qr[d0], p0, 0, 0, 0);
    if constexpr (NP == 2) { bf16x8 b1 = *reinterpret_cast<const bf16x8*>(Ks + kswz<DQK>(32 + r32, cb)); p1 = __builtin_amdgcn_mfma_f32_32x32x16_bf16(b1, qr[d0], p1, 0, 0, 0); } }
}
__device__ __forceinline__ int v_st(int k, int c) { const int kk = (k & ~0xC) | ((k & 4) << 1) | ((k & 8) >> 1); return ((kk >> 3) * 4 + (c >> 5)) * 512 + ((kk & 7) * 32 + (c & 31)) * 2; }
__device__ __forceinline__ int v_rd_base(int lane) { return ((lane & 3) << 3) | (((lane >> 2) & 3) << 6) | (((lane >> 4) & 1) << 5) | (((lane >> 5) & 1) << 8); }
constexpr int v_rd_off(int d0, int ks, int half) { return d0 * 512 + ks * 4096 + half * 2048; }
template <int OFF> __device__ __forceinline__ s16x4 tr_read(int vb) {
  s16x4 r; asm volatile("ds_read_b64_tr_b16 %0, %1 offset:%2" : "=&v"(r) : "v"(vb), "i"(OFF) : "memory"); return r;
}
#define PK(L, H) (bf16x8){L[0], L[1], L[2], L[3], H[0], H[1], H[2], H[3]}
template <int D0, int NP> __device__ __forceinline__ void pv_one(f32x16& od, int vb, bf16x8 pa0, bf16x8 pa1, bf16x8 pa2, bf16x8 pa3) {
  if constexpr (NP == 2) {
    const s16x4 l0 = tr_read<v_rd_off(D0, 0, 0)>(vb), h0 = tr_read<v_rd_off(D0, 0, 1)>(vb), l1 = tr_read<v_rd_off(D0, 1, 0)>(vb), h1 = tr_read<v_rd_off(D0, 1, 1)>(vb);
    const s16x4 l2 = tr_read<v_rd_off(D0, 2, 0)>(vb), h2 = tr_read<v_rd_off(D0, 2, 1)>(vb), l3 = tr_read<v_rd_off(D0, 3, 0)>(vb), h3 = tr_read<v_rd_off(D0, 3, 1)>(vb);
    asm volatile("s_waitcnt lgkmcnt(0)" ::: "memory"); SBAR();
    od = __builtin_amdgcn_mfma_f32_32x32x16_bf16(pa0, PK(l0, h0), od, 0, 0, 0);
    od = __builtin_amdgcn_mfma_f32_32x32x16_bf16(pa1, PK(l1, h1), od, 0, 0, 0);
    od = __builtin_amdgcn_mfma_f32_32x32x16_bf16(pa2, PK(l2, h2), od, 0, 0, 0);
    od = __builtin_amdgcn_mfma_f32_32x32x16_bf16(pa3, PK(l3, h3), od, 0, 0, 0);
  } else {
    const s16x4 l0 = tr_read<v_rd_off(D0, 0, 0)>(vb), h0 = tr_read<v_rd_off(D0, 0, 1)>(vb), l1 = tr_read<v_rd_off(D0, 1, 0)>(vb), h1 = tr_read<v_rd_off(D0, 1, 1)>(vb);
    asm volatile("s_waitcnt lgkmcnt(0)" ::: "memory"); SBAR();
    od = __builtin_amdgcn_mfma_f32_32x32x16_bf16(pa0, PK(l0, h0), od, 0, 0, 0);
    od = __builtin_amdgcn_mfma_f32_32x32x16_bf16(pa1, PK(l1, h1), od, 0, 0, 0);
  }
}
#undef PK
template <int NP> __device__ __forceinline__ void pv_d0(f32x16* o, int vb, bf16x8 pa0, bf16x8 pa1, bf16x8 pa2, bf16x8 pa3) {
  pv_one<0, NP>(o[0], vb, pa0, pa1, pa2, pa3); pv_one<1, NP>(o[1], vb, pa0, pa1, pa2, pa3); pv_one<2, NP>(o[2], vb, pa0, pa1, pa2, pa3); pv_one<3, NP>(o[3], vb, pa0, pa1, pa2, pa3);
}

template <int DQK, int KVB, int LDQ, int LDK, int LDV, int LDO>
__device__ __forceinline__ void attn_body(const bf16* __restrict__ Qb, const bf16* __restrict__ Kh, const bf16* __restrict__ Vh, unsigned char* __restrict__ Ob, const int seq, const float scale, const float* __restrict__ qgain, const int tpos0, char* lds) {
  static_assert((DQK == 128 && KVB == 64) || (DQK == 192 && KVB == 32), "supported bodies");
  constexpr int ND0 = DQK / 16, NP = KVB / 32;
  constexpr size_t SHM_V = (size_t)KVB * 128 * 2, SHM_K = (size_t)KVB * DQK * 2;
  int lane_ = threadIdx.x & 63; asm volatile("" : "+v"(lane_));
  const int wid = __builtin_amdgcn_readfirstlane(threadIdx.x >> 6), lane = lane_, tid = wid * 64 + lane, r32 = lane & 31, hi = lane >> 5;
  const float C = scale * 1.4426950408889634f, thr = 8.f / scale;
  char* V_lds = lds; char* K_lds = lds + 2 * SHM_V;
  float* ws = (float*)(lds + 2 * SHM_V + 2 * SHM_K) + wid * 64; float* li_l = ws; float* al_l = ws + 32;
  char* O_lds = lds + 2 * SHM_V + 2 * SHM_K + NW * 64 * 4 + wid * (32 * OPITCH);
  float m_reg = -1e30f, l_reg = 0; f32x16 o[4] = {}; bf16x8 qr[ND0];
  const bf16* Qw = Qb + (wid * QBLK + r32) * LDQ + hi * 8;
  { u32x4 raw[ND0]; float ss = 0.f;
#pragma unroll
    for (int d0 = 0; d0 < ND0; ++d0) raw[d0] = *reinterpret_cast<const u32x4*>(Qw + d0 * 16);
#pragma unroll
    for (int d0 = 0; d0 < ND0; ++d0) { float x[8]; x[0] = bf_lo(raw[d0].x); x[1] = bf_hi(raw[d0].x); x[2] = bf_lo(raw[d0].y); x[3] = bf_hi(raw[d0].y); x[4] = bf_lo(raw[d0].z); x[5] = bf_hi(raw[d0].z); x[6] = bf_lo(raw[d0].w); x[7] = bf_hi(raw[d0].w);
#pragma unroll
      for (int j = 0; j < 8; ++j) ss += x[j] * x[j]; }
    { auto rr = __builtin_amdgcn_permlane32_swap(__float_as_uint(ss), __float_as_uint(ss), false, false); ss = __uint_as_float(rr[0]) + __uint_as_float(rr[1]); }
    const float rs = __builtin_amdgcn_rsqf(ss * (1.f / DQK) + EPS);
    const int tq = tpos0 + wid * QBLK + r32; const float prow = (float)(tq >> 6), pcol = (float)(tq & 63);
    constexpr int RD0 = (DQK == 192) ? 8 : 0;
    constexpr int GQ = (DQK == 192) ? 1 : 2;
    constexpr float NQI = (DQK == 192) ? (1.f / 16.f) : (1.f / 32.f);
    float y[ND0][8];
#pragma unroll
    for (int d0 = 0; d0 < ND0; ++d0) { const f32x4 g0 = *(const f32x4*)(qgain + d0 * 16 + hi * 8), g1 = *(const f32x4*)(qgain + d0 * 16 + hi * 8 + 4);
      y[d0][0] = bf_lo(raw[d0].x) * rs * g0[0]; y[d0][1] = bf_hi(raw[d0].x) * rs * g0[1]; y[d0][2] = bf_lo(raw[d0].y) * rs * g0[2]; y[d0][3] = bf_hi(raw[d0].y) * rs * g0[3];
      y[d0][4] = bf_lo(raw[d0].z) * rs * g1[0]; y[d0][5] = bf_hi(raw[d0].z) * rs * g1[1]; y[d0][6] = bf_lo(raw[d0].w) * rs * g1[2]; y[d0][7] = bf_hi(raw[d0].w) * rs * g1[3]; }
    if (tpos0 >= 0) {
#pragma unroll
      for (int pr = 0; pr < 2; ++pr)
#pragma unroll
        for (int f = 0; f < GQ; ++f) { const int da = RD0 + (2 * pr) * GQ + f, db = da + GQ; const float pos = pr ? pcol : prow;
#pragma unroll
          for (int j = 0; j < 8; ++j) { const int jf = f * 16 + hi * 8 + j;
            const float fr_ = __builtin_amdgcn_exp2f(-(float)jf * NQI * 13.287712379549449f), ang = pos * fr_, cs = __cosf(ang), sn = __sinf(ang);
            const float a = y[da][j], b = y[db][j]; y[da][j] = a * cs - b * sn; y[db][j] = b * cs + a * sn; } }
    }
#pragma unroll
    for (int d0 = 0; d0 < ND0; ++d0) { u32x4 w; w.x = cvt_pk_bf16(y[d0][0], y[d0][1]); w.y = cvt_pk_bf16(y[d0][2], y[d0][3]); w.z = cvt_pk_bf16(y[d0][4], y[d0][5]); w.w = cvt_pk_bf16(y[d0][6], y[d0][7]);
      qr[d0] = *reinterpret_cast<bf16x8*>(&w); }
  }
  const int sr = tid >> 4, sc = (tid & 15) * 8;
  const int kr0 = (DQK == 128) ? sr : tid / 24, kc0 = (DQK == 128) ? sc : (tid % 24) * 8;
  const int kr1 = (DQK == 128) ? 32 + sr : (512 + tid) / 24, kc1 = (DQK == 128) ? sc : ((512 + tid) % 24) * 8;
  const bool k1v = (DQK == 128) || tid < 256;
  const int vb0 = (int)(uintptr_t)V_lds + v_rd_base(lane);
  struct { bf16x8 vs0, vs1, ks0, ks1; } sr_[2];
#define SLOAD(i, k0) do { sr_[i].vs0 = *reinterpret_cast<const bf16x8*>(&Vh[(long)((k0) + sr) * LDV + sc]); \
    if constexpr (NP == 2) sr_[i].vs1 = *reinterpret_cast<const bf16x8*>(&Vh[(long)((k0) + 32 + sr) * LDV + sc]); \
    sr_[i].ks0 = *reinterpret_cast<const bf16x8*>(&Kh[(long)((k0) + kr0) * LDK + kc0]); \
    if (k1v) sr_[i].ks1 = *reinterpret_cast<const bf16x8*>(&Kh[(long)((k0) + kr1) * LDK + kc1]); } while (0)
#define SWRITE(b, i) do { *(bf16x8*)(V_lds + (b) * SHM_V + v_st(sr, sc)) = sr_[i].vs0; \
    if constexpr (NP == 2) *(bf16x8*)(V_lds + (b) * SHM_V + v_st(32 + sr, sc)) = sr_[i].vs1; \
    *(bf16x8*)(K_lds + (b) * SHM_K + kswz<DQK>(kr0, kc0 * 2)) = sr_[i].ks0; \
    if (k1v) *(bf16x8*)(K_lds + (b) * SHM_K + kswz<DQK>(kr1, kc1 * 2)) = sr_[i].ks1; } while (0)
#define SWAIT() do { if constexpr (NP == 2) asm volatile("s_waitcnt vmcnt(4)" ::: "memory"); else { if (wid < 4) asm volatile("s_waitcnt vmcnt(3)" ::: "memory"); else asm volatile("s_waitcnt vmcnt(2)" ::: "memory"); } } while (0)
#define RESC(a) do { if (__any((a) < 1.f)) { if (hi == 0) al_l[r32] = (a); asm volatile("s_waitcnt lgkmcnt(0)" ::: "memory"); \
    for (int d = 0; d < 4; ++d) for (int r = 0; r < 16; ++r) o[d][r] *= al_l[crow(r, hi)]; } } while (0)
  f32x16 pA0, pA1, pB0, pB1; float mnA, mnB, alA, alB; bf16x8 pa0, pa1, pa2, pa3; const int NT = seq / KVB;
  constexpr int SE = 0, SO = 1;
  SLOAD(SE, 0); asm volatile("s_waitcnt vmcnt(0)" ::: "memory"); SWRITE(0, SE); __syncthreads();
  qkt<DQK, NP>(pA0, pA1, K_lds, qr, r32, hi); partialSM<NP>(pA0, pA1, m_reg, mnA, alA, C, thr);
  SLOAD(SO, KVB); if (2 < NT) SLOAD(SE, 2 * KVB);
  SWAIT(); SWRITE(1, SO); __syncthreads();
  for (int j = 1; j + 1 < NT; j += 2) {
    SBAR(); qkt<DQK, NP>(pB0, pB1, K_lds + SHM_K, qr, r32, hi);
    finishSM<NP>(pA0, pA1, alA, l_reg, pa0, pa1, pa2, pa3); SBAR();
    SLOAD(SO, (j + 2) * KVB); SBAR();
    pv_d0<NP>(o, vb0, pa0, pa1, pa2, pa3); partialSM<NP>(pB0, pB1, m_reg, mnB, alB, C, thr);
    __syncthreads(); SWAIT(); SWRITE(0, SE);
    RESC(alB); __syncthreads();
    SBAR(); qkt<DQK, NP>(pA0, pA1, K_lds, qr, r32, hi);
    finishSM<NP>(pB0, pB1, alB, l_reg, pa0, pa1, pa2, pa3); SBAR();
    if (j + 3 < NT) SLOAD(SE, (j + 3) * KVB); SBAR();
    pv_d0<NP>(o, vb0 + (int)SHM_V, pa0, pa1, pa2, pa3); partialSM<NP>(pA0, pA1, m_reg, mnA, alA, C, thr);
    __syncthreads(); SWAIT(); SWRITE(1, SO);
    RESC(alA); __syncthreads();
  }
  SBAR(); qkt<DQK, NP>(pB0, pB1, K_lds + SHM_K, qr, r32, hi);
  finishSM<NP>(pA0, pA1, alA, l_reg, pa0, pa1, pa2, pa3); SBAR();
  pv_d0<NP>(o, vb0, pa0, pa1, pa2, pa3); partialSM<NP>(pB0, pB1, m_reg, mnB, alB, C, thr);
  __syncthreads(); RESC(alB);
  finishSM<NP>(pB0, pB1, alB, l_reg, pa0, pa1, pa2, pa3); SBAR();
  pv_d0<NP>(o, vb0 + (int)SHM_V, pa0, pa1, pa2, pa3);
  if (hi == 0) li_l[r32] = l_reg; asm volatile("s_waitcnt lgkmcnt(0)" ::: "memory");
#pragma unroll
  for (int r = 0; r < 16; ++r) { const float rl = O_SCALE * __builtin_amdgcn_rcpf(li_l[crow(r, hi)]); char* rowp = O_lds + crow(r, hi) * OPITCH + r32;
#pragma unroll
    for (int d0 = 0; d0 < 4; ++d0) *(unsigned char*)(rowp + d0 * 32) = (unsigned char)(pack4_fp8(o[d0][r] * rl, 0.f, 0.f, 0.f) & 0xffu); }
  asm volatile("s_waitcnt lgkmcnt(0)" ::: "memory");
  unsigned char* Ow = Ob + (wid * QBLK) * LDO;
#pragma unroll
  for (int i = 0; i < 4; ++i) { const int row = 8 * i + (lane >> 3), cch = (lane & 7) * 16;
    const u32x4 w = *(const u32x4*)(O_lds + row * OPITCH + cch); *(u32x4*)(Ow + row * LDO + cch) = w; }
  asm volatile("s_waitcnt lgkmcnt(0)" ::: "memory");
  __syncthreads();
#undef SLOAD
#undef SWRITE
#undef SWAIT
#undef RESC
}
template <int DQK> __device__ __forceinline__ int ksw8(int row, int c16) {
    if constexpr (DQK == 128) return row * 128 + ((c16 ^ ((row >> 1) & 7)) << 4);
    else return row * 256 + ((c16 ^ (row & 15)) << 4);
}
template <int DQK> __device__ __forceinline__ void qkt8(f32x16& p0, f32x16& p1, const char* Ks, const v8i32* q8, int r32, int hi) {
  p0 = f32x16{}; p1 = f32x16{};
#pragma unroll
  for (int s_ = 0; s_ < DQK / 64; ++s_) { const int a0 = ksw8<DQK>(r32, 4 * s_ + 2 * hi), a1 = ksw8<DQK>(32 + r32, 4 * s_ + 2 * hi);
    const v8i32 b0 = __builtin_shufflevector(*reinterpret_cast<const v4i32*>(Ks + a0), *reinterpret_cast<const v4i32*>(Ks + (a0 ^ 16)), 0, 1, 2, 3, 4, 5, 6, 7);
    const v8i32 b1 = __builtin_shufflevector(*reinterpret_cast<const v4i32*>(Ks + a1), *reinterpret_cast<const v4i32*>(Ks + (a1 ^ 16)), 0, 1, 2, 3, 4, 5, 6, 7);
    p0 = __builtin_amdgcn_mfma_scale_f32_32x32x64_f8f6f4(b0, q8[s_], p0, 0, 0, 0, 0, 0, 0);
    p1 = __builtin_amdgcn_mfma_scale_f32_32x32x64_f8f6f4(b1, q8[s_], p1, 0, 0, 0, 0, 0, 0); }
}
template <int DQK, int LDQ, int LDK, int LDV, int LDO>
__device__ __forceinline__ void attn_body8(const int wid, const bf16* __restrict__ Qb, const unsigned char* __restrict__ Kh, const bf16* __restrict__ Vh, unsigned char* __restrict__ Ob, const int seq, const float scale, const float* __restrict__ qgain, const int tpos0, char* lds) {
  static_assert(DQK == 128 || DQK == 192, "supported head dims");
  constexpr int KVB = 64, NP = 2, NS = DQK / 64, KPITCH = (DQK == 128) ? 128 : 256, KPC = DQK / 16;
  constexpr size_t SHM_V = (size_t)KVB * 128 * 2, SHM_K = (size_t)KVB * KPITCH;
  int lane_ = lane_id(); asm volatile("" : "+v"(lane_));
  const int lane = lane_, tid = wid * 64 + lane, r32 = lane & 31, hi = lane >> 5;
  const float C = scale * 1.4426950408889634f, thr = 8.f / scale;
  char* V_lds = lds; char* K_lds = lds + 2 * SHM_V;
  float* ws = (float*)(lds + 2 * SHM_V + 2 * SHM_K) + wid * 64; float* li_l = ws; float* al_l = ws + 32;
  char* O_lds = lds + 2 * SHM_V + 2 * SHM_K + NW * 64 * 4 + wid * (32 * OPITCH);
  float m_reg = -1e30f, l_reg = 0; f32x16 o[4] = {}; v8i32 q8[NS];
  {
    const bf16* Qw = Qb + (wid * QBLK + r32) * LDQ + hi * 32;
    u32x4 raw[NS][4]; float ss = 0.f;
#pragma unroll
    for (int s_ = 0; s_ < NS; ++s_)
#pragma unroll
      for (int q_ = 0; q_ < 4; ++q_) raw[s_][q_] = *reinterpret_cast<const u32x4*>(Qw + s_ * 64 + q_ * 8);
    float y[NS][32];
#pragma unroll
    for (int s_ = 0; s_ < NS; ++s_)
#pragma unroll
      for (int q_ = 0; q_ < 4; ++q_) { float* x = &y[s_][q_ * 8]; x[0] = bf_lo(raw[s_][q_].x); x[1] = bf_hi(raw[s_][q_].x); x[2] = bf_lo(raw[s_][q_].y); x[3] = bf_hi(raw[s_][q_].y);
        x[4] = bf_lo(raw[s_][q_].z); x[5] = bf_hi(raw[s_][q_].z); x[6] = bf_lo(raw[s_][q_].w); x[7] = bf_hi(raw[s_][q_].w);
#pragma unroll
        for (int j = 0; j < 8; ++j) ss += x[j] * x[j]; }
    { auto rr = __builtin_amdgcn_permlane32_swap(__float_as_uint(ss), __float_as_uint(ss), false, false); ss = __uint_as_float(rr[0]) + __uint_as_float(rr[1]); }
    const float rs = __builtin_amdgcn_rsqf(ss * (1.f / DQK) + EPS);
#pragma unroll
    for (int s_ = 0; s_ < NS; ++s_)
#pragma unroll
      for (int q_ = 0; q_ < 8; ++q_) { const f32x4 g = *(const f32x4*)(qgain + s_ * 64 + hi * 32 + q_ * 4);
#pragma unroll
        for (int j = 0; j < 4; ++j) y[s_][q_ * 4 + j] *= rs * g[j]; }
    if (tpos0 >= 0) { const int tq = tpos0 + wid * QBLK + r32; const float prow = (float)(tq >> 6), pcol = (float)(tq & 63);
      if constexpr (DQK == 192) {
        const float pos = hi ? pcol : prow;
#pragma unroll
        for (int j = 0; j < 16; ++j) { const float fr_ = __builtin_amdgcn_exp2f(-(float)j * (1.f / 16.f) * 13.287712379549449f), ang = pos * fr_, cs = __cosf(ang), sn = __sinf(ang);
          const float a = y[2][j], b = y[2][16 + j]; y[2][j] = a * cs - b * sn; y[2][16 + j] = b * cs + a * sn; }
      } else {
#pragma unroll
        for (int s_ = 0; s_ < 2; ++s_) { const float pos = s_ ? pcol : prow;
#pragma unroll
          for (int j = 0; j < 32; ++j) { const float own = y[s_][j];
            auto rr = __builtin_amdgcn_permlane32_swap(__float_as_uint(own), __float_as_uint(own), false, false);
            const float oth = __uint_as_float(hi ? rr[0] : rr[1]);
            const float fr_ = __builtin_amdgcn_exp2f(-(float)j * (1.f / 32.f) * 13.287712379549449f), ang = pos * fr_, cs = __cosf(ang), sn = __sinf(ang);
            y[s_][j] = hi ? (own * cs + oth * sn) : (own * cs - oth * sn); } }
      }
    }
#pragma unroll
    for (int s_ = 0; s_ < NS; ++s_) { v8i32 w;
#pragma unroll
      for (int q_ = 0; q_ < 8; ++q_) w[q_] = (int)pack4_fp8(y[s_][4 * q_], y[s_][4 * q_ + 1], y[s_][4 * q_ + 2], y[s_][4 * q_ + 3]);
      q8[s_] = w; }
  }
  constexpr int KCH = (int)(SHM_K / 1024) / NW, VCH = (int)(SHM_V / 1024) / NW;
  const unsigned lds_u = (unsigned)(uintptr_t)lds;
  unsigned kgo[KCH], vgo[VCH];
#pragma unroll
  for (int q = 0; q < KCH; ++q) { const int o = (q * NW + wid) * 1024 + lane * 16, row = o / KPITCH, slot = (o % KPITCH) >> 4;
    const int c16 = (DQK == 128) ? (slot ^ ((row >> 1) & 7)) : (slot ^ (row & 15)); kgo[q] = (unsigned)(row * LDK + (c16 < KPC ? c16 : 0) * 16); }
#pragma unroll
  for (int q = 0; q < VCH; ++q) { const int o = (q * NW + wid) * 1024 + lane * 16, st = o >> 9, within = (o & 511) >> 1, kk = (st >> 2) * 8 + (within >> 5), c = (st & 3) * 32 + (within & 31);
    const int k = (kk & ~0xC) | ((kk & 4) << 1) | ((kk & 8) >> 1); vgo[q] = (unsigned)((k * LDV + c) * 2); }
  const int vb0 = (int)(uintptr_t)V_lds + v_rd_base(lane);
  const int NT = seq / KVB;
#define KDMA(b, t_) do { const char* kp_ = (const char*)Kh + (size_t)((t_) < NT ? (t_) : NT - 1) * KVB * LDK; _Pragma("unroll") for (int q = 0; q < KCH; ++q) \
    __builtin_amdgcn_global_load_lds((const unsigned*)(kp_ + kgo[q]), (LAS unsigned*)(size_t)(lds_u + (unsigned)(2 * SHM_V + (b) * SHM_K + (q * NW + wid) * 1024)), 16, 0, 0); } while (0)
#define VDMA(b, t_) do { const char* vp_ = (const char*)Vh + (size_t)((t_) < NT ? (t_) : NT - 1) * KVB * LDV * 2; _Pragma("unroll") for (int q = 0; q < VCH; ++q) \
    __builtin_amdgcn_global_load_lds((const unsigned*)(vp_ + vgo[q]), (LAS unsigned*)(size_t)(lds_u + (unsigned)((b) * SHM_V + (q * NW + wid) * 1024)), 16, 0, 0); } while (0)
#define DMA_WAIT() asm volatile("s_waitcnt vmcnt(0)" ::: "memory")
#define RESC(a) do { if (__any((a) < 1.f)) { if (hi == 0) al_l[r32] = (a); asm volatile("s_waitcnt lgkmcnt(0)" ::: "memory"); \
    for (int d = 0; d < 4; ++d) for (int r = 0; r < 16; ++r) o[d][r] *= al_l[crow(r, hi)]; } } while (0)
  f32x16 pA0, pA1, pB0, pB1; float mnA, mnB, alA, alB; bf16x8 pa0, pa1, pa2, pa3;
  KDMA(0, 0); VDMA(0, 0); KDMA(1, 1); DMA_WAIT(); __syncthreads();
  qkt8<DQK>(pA0, pA1, K_lds, q8, r32, hi); partialSM<NP>(pA0, pA1, m_reg, mnA, alA, C, thr);
  asm volatile("s_waitcnt lgkmcnt(0)" ::: "memory"); __syncthreads();
  KDMA(0, 2); VDMA(1, 1);
#define STEP(X0, X1, alX, Y0, Y1, mnY, alY, j_) do { SBAR(); if ((j_) + 1 < NT) qkt8<DQK>(Y0, Y1, K_lds + (((j_) + 1) & 1) * SHM_K, q8, r32, hi); \
    finishSM<NP>(X0, X1, alX, l_reg, pa0, pa1, pa2, pa3); SBAR(); \
    pv_d0<NP>(o, vb0 + ((j_) & 1) * (int)SHM_V, pa0, pa1, pa2, pa3); if ((j_) + 1 < NT) { partialSM<NP>(Y0, Y1, m_reg, mnY, alY, C, thr); RESC(alY); } \
    DMA_WAIT(); asm volatile("s_waitcnt lgkmcnt(0)" ::: "memory"); __syncthreads(); \
    KDMA(((j_) + 1) & 1, (j_) + 3); VDMA((j_) & 1, (j_) + 2); } while (0)
  for (int j = 0; j < NT; j += 2) {
    STEP(pA0, pA1, alA, pB0, pB1, mnB, alB, j);
    STEP(pB0, pB1, alB, pA0, pA1, mnA, alA, j + 1);
  }
  DMA_WAIT(); __syncthreads();
#undef STEP
#undef KDMA
#undef VDMA
#undef DMA_WAIT
  if (hi == 0) li_l[r32] = l_reg; asm volatile("s_waitcnt lgkmcnt(0)" ::: "memory");
#pragma unroll
  for (int r = 0; r < 16; ++r) { const float rl = O_SCALE * __builtin_amdgcn_rcpf(li_l[crow(r, hi)]); char* rowp = O_lds + crow(r, hi) * OPITCH + r32;
#pragma unroll
    for (int d0 = 0; d0 < 4; ++d0) *(unsigned char*)(rowp + d0 * 32) = (unsigned char)(pack4_fp8(o[d0][r] * rl, 0.f, 0.f, 0.f) & 0xffu); }
  asm volatile("s_waitcnt lgkmcnt(0)" ::: "memory");
  unsigned char* Ow = Ob + (wid * QBLK) * LDO;
#pragma unroll
  for (int i = 0; i < 4; ++i) { const int row = 8 * i + (lane >> 3), cch = (lane & 7) * 16;
    const u32x4 w = *(const u32x4*)(O_lds + row * OPITCH + cch); *(u32x4*)(Ow + row * LDO + cch) = w; }
  asm volatile("s_waitcnt lgkmcnt(0)" ::: "memory");
  __syncthreads();
#undef RESC
}
}

struct Params { const float* in[28]; float* out; unsigned char* ws; int ph_lo, ph_hi; };
typedef const __attribute__((address_space(4))) Params* KP;
enum { I_X = 0, I_C, I_CTX, I_CCTX, I_ADAW, I_ADAB, I_N1G, I_N2G, I_MLA_WDOWN, I_MLA_GQ, I_MLA_GKV, I_MLA_WUQ, I_MLA_WUKV, I_MLA_GQN, I_MLA_GKN, I_MLA_WO,
       I_GQA_WQKV, I_GQA_GQN, I_GQA_GKN, I_GQA_WO, I_MOE_WR, I_MOE_BR, I_MOE_WG, I_MOE_WU, I_MOE_WD, I_MOE_SG, I_MOE_SU, I_MOE_SD };

__device__ __forceinline__ void cvt_tile(const float* __restrict__ W, const int N, const int k0, const int n0, bf16* __restrict__ dst, const int ldk, const float* __restrict__ gain, const int mode,
                                         LAS float* scr, const int lane, const int rmap = -1, const int nbase = 0) {
    f32x4 v[16];
#pragma unroll
    for (int i = 0; i < 16; ++i) { const int kk = 4 * i + (lane >> 4); v[i] = *(const f32x4*)(W + (size_t)(k0 + kk) * N + n0 + (lane & 15) * 4); }
    if (gain) {
#pragma unroll
        for (int i = 0; i < 16; ++i) v[i] *= gain[k0 + 4 * i + (lane >> 4)]; }
#pragma unroll
    for (int i = 0; i < 16; ++i) { const int kk = 4 * i + (lane >> 4); LAS float* s = scr + kk * 65 + (lane & 15) * 4; s[0] = v[i][0]; s[1] = v[i][1]; s[2] = v[i][2]; s[3] = v[i][3]; }
    LDS_WAIT(); asm volatile("" ::: "memory");
    const int c = lane >> 3, nn = lane & 7;
#pragma unroll
    for (int jj = 0; jj < 8; ++jj) { const int n = 8 * jj + nn; const LAS float* s = scr + (8 * c) * 65 + n;
        float x[8];
#pragma unroll
        for (int j = 0; j < 8; ++j) x[j] = s[j * 65];
        u32x4 w; w.x = cvt_pk_bf16(x[0], x[1]); w.y = cvt_pk_bf16(x[2], x[3]); w.z = cvt_pk_bf16(x[4], x[5]); w.w = cvt_pk_bf16(x[6], x[7]);
        const int ng = nbase + n, orow = rmap < 0 ? n : ((ng >> 3) * 16 + rmap + (ng & 7));
        *(u32x4*)(dst + (size_t)orow * ldk + k0 + 8 * c) = w;
        if (mode == 1) { float y[8];
#pragma unroll
            for (int j = 0; j < 8; ++j) { const unsigned wj = (j & 1) ? (w[j >> 1] & 0xffff0000u) : (w[j >> 1] << 16); y[j] = x[j] - __uint_as_float(wj); }
            u32x4 w2; w2.x = cvt_pk_bf16(y[0], y[1]); w2.y = cvt_pk_bf16(y[2], y[3]); w2.z = cvt_pk_bf16(y[4], y[5]); w2.w = cvt_pk_bf16(y[6], y[7]);
            *(u32x4*)(dst + (size_t)(n + 128) * ldk + k0 + 8 * c) = w2; } }
    LDS_WAIT(); asm volatile("" ::: "memory");
}
__device__ __forceinline__ void cvt_f8_load(f32x4 (&v)[16], const float* __restrict__ W, const int N, const int k0, const int n0, const int lane) {
#pragma unroll
    for (int i = 0; i < 16; ++i) { const int kk = 8 * i + (lane >> 3); v[i] = __builtin_nontemporal_load((const f32x4*)(W + (size_t)(k0 + kk) * N + n0 + (lane & 7) * 4)); }
}
__device__ __forceinline__ void cvt_f8_finish(const f32x4 (&v)[16], const int k0, unsigned char* __restrict__ dst, const int ldk, const float scale, LAS float* scr, const int lane, const int rmap = -1, const int nbase = 0) {
#pragma unroll
    for (int i = 0; i < 16; ++i) { const int kk = 8 * i + (lane >> 3); LAS float* s = scr + kk * 33 + (lane & 7) * 4; s[0] = v[i][0] * scale; s[1] = v[i][1] * scale; s[2] = v[i][2] * scale; s[3] = v[i][3] * scale; }
    LDS_WAIT(); asm volatile("" ::: "memory");
    const int c = lane & 7, nq = lane >> 3;
#pragma unroll
    for (int jj = 0; jj < 4; ++jj) { const int n = nq + 8 * jj; const LAS float* s = scr + (16 * c) * 33 + n;
        float x[16];
#pragma unroll
        for (int j = 0; j < 16; ++j) x[j] = s[j * 33];
        u32x4 w; w.x = pack4_fp8(x[0], x[1], x[2], x[3]); w.y = pack4_fp8(x[4], x[5], x[6], x[7]); w.z = pack4_fp8(x[8], x[9], x[10], x[11]); w.w = pack4_fp8(x[12], x[13], x[14], x[15]);
        const int ng = nbase + n, orow = rmap < 0 ? n : ((ng >> 3) * 16 + rmap + (ng & 7));
        *(u32x4*)(dst + (size_t)orow * ldk + k0 + 16 * c) = w; }
    LDS_WAIT(); asm volatile("" ::: "memory");
}
__device__ __forceinline__ void cvt_tile_f8(const float* __restrict__ W, const int N, const int k0, const int n0, unsigned char* __restrict__ dst, const int ldk, const float scale, LAS float* scr, const int lane, const float* __restrict__ gain = nullptr) {
    f32x4 v[16]; cvt_f8_load(v, W, N, k0, n0, lane);
    if (gain) {
#pragma unroll
        for (int i = 0; i < 16; ++i) v[i] *= gain[k0 + 8 * i + (lane >> 3)]; }
    cvt_f8_finish(v, k0, dst, ldk, scale, scr, lane);
}
struct MoeItem { const float* W; unsigned char* dst; int N, k0, n0, ldk, rmap, nbase; float scale; };
__device__ __forceinline__ MoeItem moe_item(KP P, int idx) {
    unsigned char* ws = P->ws; MoeItem m; const int kind = idx / (2 * 64 * 256), q = idx - kind * (2 * 64 * 256), le = q >> 8, t = q & 255;
    if (kind < 2) { const int kb = t >> 4, nb = t & 15, n0 = nb * 32; m.W = P->in[kind ? I_MOE_WU : I_MOE_WG] + (size_t)le * DM * DEXP; m.N = DEXP; m.k0 = kb * 128; m.n0 = n0;
        m.dst = (unsigned char*)(ws + WS_MOE1) + ((size_t)le * 1024 + (n0 >> 7) * 256) * 2048; m.ldk = 2048; m.scale = W1_SCALE; m.rmap = kind * 8; m.nbase = n0 & 127; }
    else { const int kb = t >> 6, nb = t & 63; m.W = P->in[I_MOE_WD] + (size_t)le * DEXP * DM; m.N = DM; m.k0 = kb * 128; m.n0 = nb * 32;
        m.dst = (unsigned char*)(ws + WS_MOE2) + ((size_t)le * 2048 + nb * 32) * 512; m.ldk = 512; m.scale = W2_SCALE; m.rmap = -1; m.nbase = 0; }
    return m;
}
struct MoeBlk { const float* W; unsigned char* dst; int N, k0, n0, ldk, rmap; float scale; };
__device__ __forceinline__ MoeBlk moe_blk(KP P, int idx) {
    unsigned char* ws = P->ws; MoeBlk m; const int kind = idx / (128 * 64), q = idx - kind * (128 * 64), le = q >> 6, t = q & 63;
    if (kind < 2) { const int kb = t >> 2, nb = t & 3; m.W = P->in[kind ? I_MOE_WU : I_MOE_WG] + (size_t)le * DM * DEXP; m.N = DEXP; m.k0 = kb * 128; m.n0 = nb * 128;
        m.dst = (unsigned char*)(ws + WS_MOE1) + ((size_t)le * 1024 + nb * 256) * 2048; m.ldk = 2048; m.scale = W1_SCALE; m.rmap = kind * 8; }
    else { const int kb = t >> 4, nb = t & 15; m.W = P->in[I_MOE_WD] + (size_t)le * DEXP * DM; m.N = DM; m.k0 = kb * 128; m.n0 = nb * 128;
        m.dst = (unsigned char*)(ws + WS_MOE2) + ((size_t)le * 2048 + nb * 128) * 512; m.ldk = 512; m.scale = W2_SCALE; m.rmap = -1; }
    return m;
}
__device__ __forceinline__ void blk_load(f32x4 (&v)[8], const MoeBlk& m, int tid) {
#pragma unroll
    for (int i = 0; i < 8; ++i) v[i] = __builtin_nontemporal_load((const f32x4*)(m.W + (size_t)(m.k0 + i * 16 + (tid >> 5)) * m.N + m.n0 + (tid & 31) * 4));
}
__device__ __forceinline__ void cvt_moe_blocks(KP P, LAS float* sb, int l, int vcu, int G, int tid_) {
    constexpr int NBLK = 3 * 64 * 64, D = 3;
    int tid = tid_; asm volatile("" : "+v"(tid));
    const int per = (NBLK + G - 1) / G; const int it0 = vcu * per; const int end = it0 + per < NBLK ? it0 + per : NBLK;
    if (it0 >= end) return;
#define MOE_BLK_L(j) moe_blk(P, ((j) >> 12) * (128 * 64) + l * 4096 + ((j) & 4095))
    f32x4 v[D][8];
#pragma unroll
    for (int d = 0; d < D; ++d) { const int j = it0 + d < end ? it0 + d : end - 1; const MoeBlk m = MOE_BLK_L(j); blk_load(v[d], m, tid); }
    int p = 0;
    for (int base = it0; base < end; base += D) {
#pragma unroll
        for (int d = 0; d < D; ++d) { const int cur = base + d < end ? base + d : end - 1;
            const MoeBlk mc = MOE_BLK_L(cur); LAS float* sp = sb + p * (128 * 128);
#pragma unroll
            for (int i = 0; i < 8; ++i) { const int k = i * 16 + (tid >> 5); *(LAS f32x4*)(sp + k * 128 + (((tid & 31) * 4) ^ (4 * ((k >> 4) & 7)))) = v[d][i] * mc.scale; }
            { const int jn = cur + D < end ? cur + D : end - 1; const MoeBlk mn = MOE_BLK_L(jn); blk_load(v[d], mn, tid); }
            LDS_WAIT(); __syncthreads();
            { const int n = tid >> 2, c = tid & 3; u32x4 w0, w1; float x[32];
#pragma unroll
              for (int j = 0; j < 32; ++j) { const int k = 32 * c + j; x[j] = sp[k * 128 + (n ^ (4 * ((k >> 4) & 7)))]; }
              w0.x = pack4_fp8(x[0], x[1], x[2], x[3]); w0.y = pack4_fp8(x[4], x[5], x[6], x[7]); w0.z = pack4_fp8(x[8], x[9], x[10], x[11]); w0.w = pack4_fp8(x[12], x[13], x[14], x[15]);
              w1.x = pack4_fp8(x[16], x[17], x[18], x[19]); w1.y = pack4_fp8(x[20], x[21], x[22], x[23]); w1.z = pack4_fp8(x[24], x[25], x[26], x[27]); w1.w = pack4_fp8(x[28], x[29], x[30], x[31]);
              const int orow = mc.rmap < 0 ? n : ((n >> 3) * 16 + mc.rmap + (n & 7));
              unsigned char* dd = mc.dst + (size_t)orow * mc.ldk + mc.k0 + 32 * c; __builtin_nontemporal_store(w0, (u32x4*)dd); __builtin_nontemporal_store(w1, (u32x4*)(dd + 16)); }
            p ^= 1;
        }
    }
    LDS_WAIT(); __syncthreads();
#undef MOE_BLK_L
}
__device__ __forceinline__ float silu_f(float x) { return x / (1.f + __expf(-x)); }
__device__ __forceinline__ void mod_block(KP P, float* mod, LAS float* red, int blk, int wave, int lane, int tid) {
    const int l = blk / 48, nb = blk % 48, k0 = wave * 256, n = nb * 256 + lane * 4;
    const float* W = P->in[I_ADAW] + (size_t)l * DM * NMOD; const float* cc = P->in[I_C]; const float* cx = P->in[I_CCTX];
    f32x4 a[9];
#pragma unroll
    for (int r = 0; r < 9; ++r) a[r] = (f32x4){0.f, 0.f, 0.f, 0.f};
    for (int kb = 0; kb < 256; kb += 64) {
        float s[9];
#pragma unroll
        for (int r = 0; r < 8; ++r) s[r] = silu_f(cc[r * DM + k0 + kb + lane]);
        s[8] = silu_f(cx[k0 + kb + lane]);
#pragma unroll 4
        for (int j = 0; j < 64; ++j) { const f32x4 w = *(const f32x4*)(W + (size_t)(k0 + kb + j) * NMOD + n);
#pragma unroll
            for (int r = 0; r < 9; ++r) { const float sj = __uint_as_float(__builtin_amdgcn_readlane((int)__float_as_uint(s[r]), j)); a[r] += w * sj; } }
    }
#pragma unroll
    for (int r = 0; r < 9; ++r) *(LAS f32x4*)(red + (wave * 9 + r) * 256 + lane * 4) = a[r];
    LDS_WAIT(); __syncthreads();
    for (int o = tid; o < 9 * 256; o += NTHREADS) { const int r = o >> 8, c = o & 255; float t = P->in[I_ADAB][(size_t)l * NMOD + nb * 256 + c];
#pragma unroll
        for (int w = 0; w < 8; ++w) t += red[(w * 9 + r) * 256 + c];
        mod[((size_t)l * 9 + r) * NMOD + nb * 256 + c] = t; }
    __syncthreads();
}
__device__ __forceinline__ void p0_prologue(KP P, LAS unsigned char* lds, int vcu, int G, int gw, int NGW, int wave, int lane) {
    unsigned char* ws = P->ws;
    LAS float* scr = (LAS float*)(lds + wave * 16896);
    float* mod = (float*)(ws + WS_CTL + CTL_MOD);
    for (int blk = vcu; blk < 96; blk += G) mod_block(P, mod, (LAS float*)lds, blk, wave, lane, wave * 64 + lane);
    constexpr int N_MOD = 0, N_ZERO = 192 + 2 * 128;
    constexpr int T_DOWN = 32 * 21, T_UQ = 12 * 48, T_UKV = 8 * 64, T_WO = 32 * 32, T_QKV = 32 * 48, T_SG = 2 * 32 * 8, T_SD = 2 * 8 * 32, T_R = 2 * 32;
    constexpr int NITEMS = N_MOD + N_ZERO + T_DOWN + T_UQ + T_UKV + T_WO + T_QKV + T_WO + T_SG + T_SG + T_SD + T_R;
    for (int it = gw; it < NITEMS; it += NGW) {
        int r = it;
        if (r < N_ZERO) {
            bf16* row;
            if (r < 192) { if (r >= 96) continue; row = (bf16*)((unsigned char*)(ws + WS_BT_DOWN) + (size_t)1344 * 2048 + (size_t)r * 4096); }
            else { const int q = r - 192, l = q >> 7, j = q & 127; row = (bf16*)(ws + WS_BT_R) + ((size_t)l * 256 + (j < 64 ? 64 + j : 128 + j)) * 2048; }
            const u32x4 z = {0u, 0u, 0u, 0u};
#pragma unroll
            for (int j = 0; j < 4; ++j) *(u32x4*)(row + (j * 64 + lane) * 8) = z;
            continue; } r -= N_ZERO;
        if (r < T_DOWN) { const int kb = r / 42, nb = r % 42; cvt_tile_f8(P->in[I_MLA_WDOWN], 1344, kb * 128, nb * 32, (unsigned char*)(ws + WS_BT_DOWN) + (size_t)(nb * 32) * 2048, 2048, W1_SCALE, scr, lane); continue; } r -= T_DOWN;
        if (r < T_UQ) { const int kb = r / 96, nb = r % 96; cvt_tile_f8(P->in[I_MLA_WUQ], 3072, kb * 128, nb * 32, (unsigned char*)(ws + WS_BT_UQ) + (size_t)(nb * 32) * 768, 768, W2_SCALE, scr, lane, P->in[I_MLA_GQ]); continue; } r -= T_UQ;
        if (r < T_UKV) { const int kb = r / 128, nb = r % 128; cvt_tile_f8(P->in[I_MLA_WUKV], 4096, kb * 128, nb * 32, (unsigned char*)(ws + WS_BT_UKV) + (size_t)(nb * 32) * 512, 512, W2_SCALE, scr, lane, P->in[I_MLA_GKV]); continue; } r -= T_UKV;
        if (r < T_WO) { const int kb = r / 64, nb = r % 64; cvt_tile_f8(P->in[I_MLA_WO], 2048, kb * 128, nb * 32, (unsigned char*)(ws + WS_BT_WO0) + (size_t)(nb * 32) * 2048, 2048, W1_SCALE, scr, lane); continue; } r -= T_WO;
        if (r < T_QKV) { const int kb = r / 96, nb = r % 96; cvt_tile_f8(P->in[I_GQA_WQKV], 3072, kb * 128, nb * 32, (unsigned char*)(ws + WS_BT_QKV) + (size_t)(nb * 32) * 2048, 2048, W1_SCALE, scr, lane); continue; } r -= T_QKV;
        if (r < T_WO) { const int kb = r / 64, nb = r % 64; cvt_tile_f8(P->in[I_GQA_WO], 2048, kb * 128, nb * 32, (unsigned char*)(ws + WS_BT_WO1) + (size_t)(nb * 32) * 2048, 2048, W1_SCALE, scr, lane); continue; } r -= T_WO;
        if (r < 2 * T_SG) { const int up = r / T_SG, q = r % T_SG, l = q / 256, t = q % 256, kb = t / 16, nb = t % 16, n0 = nb * 32;
            f32x4 v[16]; const float* W = P->in[up ? I_MOE_SU : I_MOE_SG] + (size_t)l * DM * DEXP; cvt_f8_load(v, W, DEXP, kb * 128, n0, lane);
            cvt_f8_finish(v, kb * 128, (unsigned char*)(ws + WS_BT_S1) + ((size_t)l * 1024 + (n0 >> 7) * 256) * 2048, 2048, W1_SCALE, scr, lane, up * 8, n0 & 127); continue; } r -= 2 * T_SG;
        if (r < T_SD) { const int l = r / 256, t = r % 256, kb = t / 64, nb = t % 64; cvt_tile_f8(P->in[I_MOE_SD] + (size_t)l * DEXP * DM, DM, kb * 128, nb * 32, (unsigned char*)(ws + WS_BT_S2) + ((size_t)l * 2048 + nb * 32) * 512, 512, W2_SCALE, scr, lane); continue; } r -= T_SD;
        if (r < T_R) { const int l = r / 32, kb = r % 32; cvt_tile(P->in[I_MOE_WR] + (size_t)l * DM * NEXP, NEXP, kb * 64, 0, (bf16*)(ws + WS_BT_R) + (size_t)l * 256 * 2048, 2048, nullptr, 1, scr, lane); continue; } r -= T_R;
        (void)r;
    }
    __syncthreads();
}

__device__ __forceinline__ void row_load_bf(const bf16* p, int lane, f32x4 (&v)[8]) {
#pragma unroll
    for (int j = 0; j < 8; ++j) { const u32x2 w = __builtin_nontemporal_load((const u32x2*)(p + j * 256 + lane * 4)); v[j] = (f32x4){bf_lo(w.x), bf_hi(w.x), bf_lo(w.y), bf_hi(w.y)}; }
}
__device__ __forceinline__ void row_load(const float* p, int lane, f32x4 (&v)[8]) {
#pragma unroll
    for (int j = 0; j < 8; ++j) v[j] = __builtin_nontemporal_load((const f32x4*)(p + j * 256 + lane * 4));
}
__device__ __forceinline__ void norm_mod_store(const f32x4 (&v)[8], const float* g, const float* sh, const float* sc, bf16* out, int lane, unsigned char* out8 = nullptr) {
    float ss = 0.f;
#pragma unroll
    for (int j = 0; j < 8; ++j) ss += (v[j][0] * v[j][0] + v[j][1] * v[j][1]) + (v[j][2] * v[j][2] + v[j][3] * v[j][3]);
    const float rs = __builtin_amdgcn_rsqf(wave_sum(ss) * (1.f / DM) + EPS);
#pragma unroll
    for (int j = 0; j < 8; ++j) { const int c = j * 256 + lane * 4; const f32x4 gg = *(const f32x4*)(g + c), s1 = *(const f32x4*)(sc + c), s0 = *(const f32x4*)(sh + c);
        const f32x4 y = v[j] * rs * gg * (s1 + 1.f) + s0; if (out) { u32x2 w; w.x = cvt_pk_bf16(y[0], y[1]); w.y = cvt_pk_bf16(y[2], y[3]); *(u32x2*)(out + c) = w; }
        if (out8) *(unsigned*)(out8 + c) = pack4_fp8(y[0], y[1], y[2], y[3]); }
}
__device__ __forceinline__ void mod_load(const float* g, const float* sh, const float* sc, int lane, f32x4 (&gg)[8], f32x4 (&s0)[8]) {
#pragma unroll
    for (int j = 0; j < 8; ++j) { const int c = j * 256 + lane * 4; gg[j] = *(const f32x4*)(g + c) * (*(const f32x4*)(sc + c) + 1.f); s0[j] = *(const f32x4*)(sh + c); }
}
__device__ __forceinline__ void norm_apply(const f32x4 (&v)[8], const f32x4 (&gg)[8], const f32x4 (&s0)[8], int lane, bf16* out, unsigned char* out8) {
    float ss = 0.f;
#pragma unroll
    for (int j = 0; j < 8; ++j) ss += (v[j][0] * v[j][0] + v[j][1] * v[j][1]) + (v[j][2] * v[j][2] + v[j][3] * v[j][3]);
    const float rs = __builtin_amdgcn_rsqf(wave_sum(ss) * (1.f / DM) + EPS);
#pragma unroll
    for (int j = 0; j < 8; ++j) { const int c = j * 256 + lane * 4; const f32x4 y = v[j] * rs * gg[j] + s0[j];
        if (out) { u32x2 w; w.x = cvt_pk_bf16(y[0], y[1]); w.y = cvt_pk_bf16(y[2], y[3]); *(u32x2*)(out + c) = w; }
        if (out8) *(unsigned*)(out8 + c) = pack4_fp8(y[0], y[1], y[2], y[3]); }
}
__device__ __forceinline__ void row_info(int T, int& b, int& p, int& r) { b = T / TPB; p = T - b * TPB; r = p < CTXL ? 8 : b; }

__device__ __forceinline__ void rope8(float (&y)[8], const float (&yp)[8], float pos, int j0, float nq_inv, bool second) {
#pragma unroll
    for (int j = 0; j < 8; ++j) { const float f = __builtin_amdgcn_exp2f(-(float)(j0 + j) * nq_inv * 13.287712379549449f);
        const float ang = pos * f; const float cs = __cosf(ang), sn = __sinf(ang);
        y[j] = second ? (y[j] * cs + yp[j] * sn) : (y[j] * cs - yp[j] * sn); }
}
__device__ __forceinline__ void unpack8(const u32x4 w, float (&x)[8]) { x[0] = bf_lo(w.x); x[1] = bf_hi(w.x); x[2] = bf_lo(w.y); x[3] = bf_hi(w.y); x[4] = bf_lo(w.z); x[5] = bf_hi(w.z); x[6] = bf_lo(w.w); x[7] = bf_hi(w.w); }
__device__ __forceinline__ u32x4 pack8f(const float (&y)[8]) { u32x4 w; w.x = cvt_pk_bf16(y[0], y[1]); w.y = cvt_pk_bf16(y[2], y[3]); w.z = cvt_pk_bf16(y[4], y[5]); w.w = cvt_pk_bf16(y[6], y[7]); return w; }

__device__ __forceinline__ void mla_finalize_token(KP P, int T, int lane) {
    unsigned char* ar = P->ws + WS_ARENA;
    const bf16* qraw = (const bf16*)(ar + AR_QRAW) + (size_t)T * 3072; const bf16* kvraw = (const bf16*)(ar + AR_KVRAW) + (size_t)T * 4096; const unsigned char* down = (const unsigned char*)(ar + AR_DOWN) + (size_t)T * 1536;
    unsigned char* kf = (unsigned char*)(ar + AR_KF) + (size_t)T * 3072;
    int b, p, rr; row_info(T, b, p, rr); const bool rot = p >= CTXL; const int t = p - CTXL; const float prow = (float)(t >> 6), pcol = (float)(t & 63);
    const int c = lane & 31, half = lane >> 5; const bool act = c < 24; const int cc = act ? c : 0;
    const int rc = cc - 16, quarter = rc >> 1; const bool isrope = cc >= 16;
#pragma unroll
    for (int which = 1; which < 2; ++which) {
        const float* gain = P->in[which ? I_MLA_GKN : I_MLA_GQN] + cc * 8;
        const f32x4 g0 = *(const f32x4*)gain, g1 = *(const f32x4*)(gain + 4);
        for (int hs = 0; hs < 8; ++hs) { const int h = hs * 2 + half;
            float x[8];
            if (isrope) { const u32x2 w8 = *(const u32x2*)(down + 1280 + rc * 8);
                const f32x2 p0 = __builtin_amdgcn_cvt_pk_f32_fp8((int)w8.x, false), p1 = __builtin_amdgcn_cvt_pk_f32_fp8((int)w8.x, true), p2 = __builtin_amdgcn_cvt_pk_f32_fp8((int)w8.y, false), p3 = __builtin_amdgcn_cvt_pk_f32_fp8((int)w8.y, true);
                x[0] = p0[0]; x[1] = p0[1]; x[2] = p1[0]; x[3] = p1[1]; x[4] = p2[0]; x[5] = p2[1]; x[6] = p3[0]; x[7] = p3[1]; }
            else { const u32x4 w = *(const u32x4*)(kvraw + h * 256 + cc * 8); unpack8(w, x); }
            float ss = 0.f;
#pragma unroll
            for (int j = 0; j < 8; ++j) ss += x[j] * x[j];
            if (!act) ss = 0.f;
#pragma unroll
            for (int o = 1; o < 32; o <<= 1) ss += __shfl_xor(ss, o);
            const float rs = __builtin_amdgcn_rsqf(ss * (1.f / 192.f) + EPS);
            float y[8], yp[8];
#pragma unroll
            for (int j = 0; j < 4; ++j) { y[j] = x[j] * rs * g0[j]; y[4 + j] = x[4 + j] * rs * g1[j]; }
#pragma unroll
            for (int j = 0; j < 8; ++j) yp[j] = __shfl_xor(y[j], 2);
            if (rot && isrope) rope8(y, yp, quarter < 2 ? prow : pcol, (rc & 1) * 8, 1.f / 16.f, (quarter & 1) != 0);
            if (act) { u32x2 q8_; q8_.x = pack4_fp8(y[0], y[1], y[2], y[3]); q8_.y = pack4_fp8(y[4], y[5], y[6], y[7]); *(u32x2*)(kf + h * 192 + cc * 8) = q8_; }
        }
    }
}
__device__ __forceinline__ void gqa_finalize_token(KP P, int T, int lane) {
    unsigned char* ar = P->ws + WS_ARENA;
    const bf16* raw = (const bf16*)(ar + AR_QRAW) + (size_t)T * 3072;
    unsigned char* kf = (unsigned char*)(ar + AR_KF) + (size_t)T * 512;
    int b, p, rr; row_info(T, b, p, rr); const bool rot = p >= CTXL; const int t = p - CTXL; const float prow = (float)(t >> 6), pcol = (float)(t & 63);
    const int c = lane & 15, grp = lane >> 4, quarter = c >> 2;
    for (int step = 4; step < 5; ++step) {
        const bool isk = step == 4; const int h = isk ? grp : step * 4 + grp;
        const float* gain = P->in[isk ? I_GQA_GKN : I_GQA_GQN] + c * 8;
        const f32x4 g0 = *(const f32x4*)gain, g1 = *(const f32x4*)(gain + 4);
        const bf16* src = raw + (isk ? 2048 : 0) + h * 128 + c * 8;
        u32x4 w = *(const u32x4*)src; float x[8]; unpack8(w, x);
        float ss = 0.f;
#pragma unroll
        for (int j = 0; j < 8; ++j) ss += x[j] * x[j];
#pragma unroll
        for (int o = 1; o < 16; o <<= 1) ss += __shfl_xor(ss, o);
        const float rs = __builtin_amdgcn_rsqf(ss * (1.f / 128.f) + EPS);
        float y[8], yp[8];
#pragma unroll
        for (int j = 0; j < 4; ++j) { y[j] = x[j] * rs * g0[j]; y[4 + j] = x[4 + j] * rs * g1[j]; }
#pragma unroll
        for (int j = 0; j < 8; ++j) yp[j] = __shfl_xor(y[j], 4);
        if (rot) rope8(y, yp, quarter < 2 ? prow : pcol, (c & 3) * 8, 1.f / 32.f, (quarter & 1) != 0);
        { u32x2 q8_; q8_.x = pack4_fp8(y[0], y[1], y[2], y[3]); q8_.y = pack4_fp8(y[4], y[5], y[6], y[7]); *(u32x2*)(kf + h * 128 + c * 8) = q8_; }
    }
}

__device__ __forceinline__ void route_select(KP P, int layer, int T, int lane, bool& sel, float& w, int& rank) {
    const float* lp = (const float*)(P->ws + WS_ARENA + AR_LOGIT4) + (size_t)T * 64 + lane;
    const float x = (lp[0] + lp[(size_t)MT * 64]) + (lp[(size_t)2 * MT * 64] + lp[(size_t)3 * MT * 64]);
    const float s = 1.f / (1.f + __expf(-x));
    const float bsc = s + P->in[I_MOE_BR][layer * 64 + lane];
    float m1 = bsc;
#pragma unroll
    for (int o = 1; o < 8; o <<= 1) m1 = fmaxf(m1, __shfl_xor(m1, o));
    int i1 = (bsc == m1) ? lane : 64;
#pragma unroll
    for (int o = 1; o < 8; o <<= 1) i1 = min(i1, __shfl_xor(i1, o));
    float m2 = (lane == i1) ? -INFINITY : bsc;
#pragma unroll
    for (int o = 1; o < 8; o <<= 1) m2 = fmaxf(m2, __shfl_xor(m2, o));
    const float gs = m1 + m2; const int g = lane >> 3;
    int grank = 0;
#pragma unroll
    for (int q = 0; q < 8; ++q) { const float o = __shfl(gs, q * 8); grank += (o > gs || (o == gs && q < g)) ? 1 : 0; }
    const bool gsel = grank < 4;
    const float mb = gsel ? bsc : -INFINITY;
    rank = 0;
    for (int q = 0; q < 64; ++q) { const float o = __uint_as_float(__builtin_amdgcn_readlane((int)__float_as_uint(mb), q)); rank += (o > mb || (o == mb && q < lane)) ? 1 : 0; }
    sel = gsel && rank < 8;
    const float wsum = wave_sum(sel ? s : 0.f);
    w = s / wsum * 2.5f;
}
template <bool LAT> __device__ __forceinline__ void route_phase(KP P, int layer, LAS unsigned char* lds, int ntok, int vcu, int G, int wave, int lane, int tid) {
    constexpr int MAXS = 12;
    LAS int* hist = (LAS int*)lds; LAS int* base = hist + 64; LAS int* stash = base + 64; LAS float* stashw = (LAS float*)(stash + MAXS * 8 * 64);
    unsigned char* ws = P->ws; int* cnt = (int*)(ws + WS_CTL) + CW_CNT + layer * 64 * CNT_STRIDE;
    int* list = (int*)(ws + WS_LIST); float* wlist = (float*)(ws + WS_WLIST); int* asg = (int*)(ws + WS_ASG);
    const int nstep_all = (ntok + G * 8 - 1) / (G * 8);
    for (int s0 = 0; s0 < nstep_all; s0 += MAXS) {
        const int ns = (nstep_all - s0) < MAXS ? (nstep_all - s0) : MAXS;
        if (tid < 64) hist[tid] = 0;
        LDS_WAIT(); __syncthreads();
        for (int i = 0; i < ns; ++i) { const int j = ((s0 + i) * G + vcu) * 8 + wave; int pk = 0; float w = 0.f;
            if (j < ntok) { const int T = LAT ? (j >> 11) * TPB + CTXL + (j & 2047) : j; bool sel; int rank; route_select(P, layer, T, lane, sel, w, rank);
                if (sel) { const int ls = __hip_atomic_fetch_add(hist + lane, 1, __ATOMIC_RELAXED, __HIP_MEMORY_SCOPE_WORKGROUP); pk = ls | (rank << 20) | (1 << 31); } }
            stash[(i * 8 + wave) * 64 + lane] = pk; stashw[(i * 8 + wave) * 64 + lane] = w; }
        LDS_WAIT(); __syncthreads();
        if (tid < 64) { const int h = hist[tid]; base[tid] = h ? atomicAdd(cnt + tid * CNT_STRIDE, h) : 0; }
        LDS_WAIT(); __syncthreads();
        for (int i = 0; i < ns; ++i) { const int j = ((s0 + i) * G + vcu) * 8 + wave;
            if (j < ntok) { const int T = LAT ? (j >> 11) * TPB + CTXL + (j & 2047) : j; const int pk = stash[(i * 8 + wave) * 64 + lane];
                if (pk < 0) { const int slot = base[lane] + (pk & 0xfffff), rank = (pk >> 20) & 15;
                    list[(size_t)lane * CAP + slot] = T; wlist[(size_t)lane * CAP + slot] = stashw[(i * 8 + wave) * 64 + lane]; asg[(size_t)T * 8 + rank] = (lane << 16) | slot; } } }
        __syncthreads();
    }
}

__device__ __forceinline__ void moe_prefix(const int* cnt, LAS int* ublk, int tid) {
    if (tid < 64) { const int nb = (cnt[tid * CNT_STRIDE] + 255) >> 8; int inc = nb;
#pragma unroll
        for (int o = 1; o < 64; o <<= 1) { const int t = __shfl_up(inc, o); if (tid >= o) inc += t; }
        ublk[tid] = inc - nb; if (tid == 63) ublk[64] = inc; }
    LDS_WAIT(); __syncthreads();
    { const int tot = ublk[64]; LAS unsigned short* bexp = (LAS unsigned short*)(ublk + 128);
      for (int mbg = tid; mbg < tot; mbg += NTHREADS) { int lo = 0, hi = NEXP - 1;
          while (lo < hi) { const int mid = (lo + hi + 1) >> 1; if (ublk[mid] <= mbg) lo = mid; else hi = mid - 1; }
          bexp[mbg] = (unsigned short)lo; } }
    LDS_WAIT(); __syncthreads();
}

__device__ __forceinline__ void comb_mod_load(KP P, int layer, int r, int lane, float (&gtv)[4][8], float (&gg1)[4][8], float (&s01)[4][8]) {
    const float* mod = (const float*)(P->ws + WS_CTL + CTL_MOD) + ((size_t)layer * 9 + r) * NMOD; const float* gt = mod + 5 * DM;
#pragma unroll
    for (int j = 0; j < 4; ++j) { const int c = j * 512 + lane * 8; const f32x4 g0 = *(const f32x4*)(gt + c), g1 = *(const f32x4*)(gt + c + 4);
#pragma unroll
        for (int i = 0; i < 4; ++i) { gtv[j][i] = g0[i]; gtv[j][4 + i] = g1[i]; } }
    if (layer == 0) { const float* mod1 = (const float*)(P->ws + WS_CTL + CTL_MOD) + ((size_t)9 + r) * NMOD; const float* g = P->in[I_N1G] + DM;
#pragma unroll
        for (int j = 0; j < 4; ++j) { const int c = j * 512 + lane * 8;
#pragma unroll
            for (int q = 0; q < 2; ++q) { const f32x4 gv = *(const f32x4*)(g + c + 4 * q), sc = *(const f32x4*)(mod1 + DM + c + 4 * q), sh = *(const f32x4*)(mod1 + c + 4 * q);
#pragma unroll
                for (int i = 0; i < 4; ++i) { gg1[j][4 * q + i] = gv[i] * (1.f + sc[i]); s01[j][4 * q + i] = sh[i]; } } } }
}
__device__ __forceinline__ void combine_row(KP P, int layer, int T, int sh_block, const LAS int* ublk, int lane, const float (&gtv)[4][8], const float (&gg1)[4][8], const float (&s01)[4][8]) {
    unsigned char* ws = P->ws;
    int b, p, r; row_info(T, b, p, r);
    bf16* h = (bf16*)(ws + WS_H) + (size_t)T * DM; const int* asg = (const int*)(ws + WS_ASG) + (size_t)T * 8;
    float a[4][8];
#pragma unroll
    for (int j = 0; j < 4; ++j)
#pragma unroll
        for (int i = 0; i < 8; ++i) a[j][i] = 0.f;
    const int my = asg[lane & 7];
    const unsigned char* Y8 = (const unsigned char*)(ws + WS_ARENA + AR_Y);
#pragma unroll 4
    for (int k = 0; k < 8; ++k) {
        const int v = __builtin_amdgcn_readlane(my, k);
        const unsigned char* yp = Y8 + ((size_t)ublk[v >> 16] * 256 + (v & 0xffff)) * DM + lane * 8;
        u32x2 w[4];
#pragma unroll
        for (int j = 0; j < 4; ++j) w[j] = __builtin_nontemporal_load((const u32x2*)(yp + j * 512));
#pragma unroll
        for (int j = 0; j < 4; ++j) { const f32x2 p0 = __builtin_amdgcn_cvt_pk_f32_fp8((int)w[j].x, false), p1 = __builtin_amdgcn_cvt_pk_f32_fp8((int)w[j].x, true),
                                                  p2 = __builtin_amdgcn_cvt_pk_f32_fp8((int)w[j].y, false), p3 = __builtin_amdgcn_cvt_pk_f32_fp8((int)w[j].y, true);
            a[j][0] += p0[0]; a[j][1] += p0[1]; a[j][2] += p1[0]; a[j][3] += p1[1]; a[j][4] += p2[0]; a[j][5] += p2[1]; a[j][6] += p3[0]; a[j][7] += p3[1]; }
    }
    { const unsigned char* yp = (const unsigned char*)(ws + WS_ARENA + AR_YS) + (size_t)T * DM + lane * 8;
        u32x2 w[4];
#pragma unroll
        for (int j = 0; j < 4; ++j) w[j] = *(const u32x2*)(yp + j * 512);
#pragma unroll
        for (int j = 0; j < 4; ++j) { const f32x2 p0 = __builtin_amdgcn_cvt_pk_f32_fp8((int)w[j].x, false), p1 = __builtin_amdgcn_cvt_pk_f32_fp8((int)w[j].x, true),
                                                  p2 = __builtin_amdgcn_cvt_pk_f32_fp8((int)w[j].y, false), p3 = __builtin_amdgcn_cvt_pk_f32_fp8((int)w[j].y, true);
            a[j][0] += p0[0]; a[j][1] += p0[1]; a[j][2] += p1[0]; a[j][3] += p1[1]; a[j][4] += p2[0]; a[j][5] += p2[1]; a[j][6] += p3[0]; a[j][7] += p3[1]; }
#pragma unroll
        for (int j = 0; j < 4; ++j)
#pragma unroll
            for (int i = 0; i < 8; ++i) a[j][i] *= (1.f / Y_SCALE); }
    float ss = 0.f;
#pragma unroll
    for (int j = 0; j < 4; ++j) { const int c = j * 512 + lane * 8;
        float hx[8]; unpack8(*(const u32x4*)(h + c), hx);
#pragma unroll
        for (int i = 0; i < 8; ++i) a[j][i] = hx[i] + gtv[j][i] * a[j][i];
#pragma unroll
        for (int i = 0; i < 8; ++i) ss += a[j][i] * a[j][i]; }
    if (layer == 1) { float* o = P->out + ((size_t)b * SEQ + (p - CTXL)) * DM;
#pragma unroll
        for (int j = 0; j < 4; ++j) { const int c = j * 512 + lane * 8; *(f32x4*)(o + c) = (f32x4){a[j][0], a[j][1], a[j][2], a[j][3]}; *(f32x4*)(o + c + 4) = (f32x4){a[j][4], a[j][5], a[j][6], a[j][7]}; }
        return; }
    const float rs = __builtin_amdgcn_rsqf(wave_sum(ss) * (1.f / DM) + EPS);
    unsigned char* ao = (unsigned char*)(ws + WS_ACT) + (size_t)T * DM;
#pragma unroll
    for (int j = 0; j < 4; ++j) { const int c = j * 512 + lane * 8;
        *(u32x4*)(h + c) = pack8f(a[j]);
        float y[8];
#pragma unroll
        for (int i = 0; i < 8; ++i) y[i] = a[j][i] * rs * gg1[j][i] + s01[j][i];
        u32x2 q8; q8.x = pack4_fp8(y[0], y[1], y[2], y[3]); q8.y = pack4_fp8(y[4], y[5], y[6], y[7]); *(u32x2*)(ao + c) = q8; }
}

enum Phase { PH_P0 = 0, PH_NORM1, PH_DOWN, PH_UP, PH_FIN0, PH_ATT0, PH_WO0, PH_NORM2_0, PH_ROUTER0, PH_TOPK0, PH_G1_0, PH_G2_0, PH_COMB0,
             PH_QKV, PH_FIN1, PH_ATT1, PH_WO1, PH_NORM2_1, PH_ROUTER1, PH_TOPK1, PH_G1_1, PH_G2_1, PH_COMB1, PH_COUNT };

#ifndef LB2
#define LB2 2
#endif
__global__ void __launch_bounds__(NTHREADS, LB2) mega_fwd(Params P_unused) {
    extern __shared__ __attribute__((aligned(16))) unsigned char lds_raw[];
    const KP P0 = (KP)__builtin_amdgcn_kernarg_segment_ptr();
    LAS unsigned char* lds = (LAS unsigned char*)lds_raw;
    volatile LAS unsigned* MISC = (volatile LAS unsigned*)(lds + LDS_MISC);
    LAS int* ublk = (LAS int*)(lds + LDS_MISC + 64);
    const int wave0 = __builtin_amdgcn_readfirstlane(threadIdx.x >> 6);
    if (threadIdx.x < 2) MISC[threadIdx.x] = 0u;
    __syncthreads();
    XcdBarrier bar; bar.bar = (unsigned*)(P0->ws + WS_CTL) + CW_BAR; bar.x = 0; bar.st = nullptr;
    bar.wave = wave0;
    if (!MK_PER_PHASE) bar = xcd_barrier_post((unsigned*)(P0->ws + WS_CTL) + CW_BAR, MISC, wave0);
    const int lo = P0->ph_lo, hi = P0->ph_hi;
#ifndef PH_MASK
#define PH_MASK 0xFFFFFFFFu
#endif
#define IN(k) ((((PH_MASK) >> (k)) & 1u) && lo <= (k) && (k) < hi)
#define PH_BEGIN KP P = P0; asm volatile("" : "+s"(P)); int lane = lane_id(); asm volatile("" : "+v"(lane)); \
    const int wave = wave0, tid = wave * 64 + lane; \
    const int G = gridDim.x, bx = blockIdx.x, vcu = (G % 8 == 0) ? (bx % 8) * (G / 8) + bx / 8 : bx, gw = vcu * NWAVES + wave, NGW = G * NWAVES; \
    unsigned char* ws = P->ws; unsigned char* ar = ws + WS_ARENA; unsigned* ctl = (unsigned*)(ws + WS_CTL); \
    float* mod = (float*)(ws + WS_CTL + CTL_MOD); float* ssq = (float*)(ws + WS_SSQP); bf16* hbuf = (bf16*)(ws + WS_H); \
    (void)tid; (void)gw; (void)NGW; (void)ar; (void)ctl; (void)mod; (void)ssq; (void)hbuf; (void)vcu; (void)bx
#define SEAM(k) do { if (IN(k) && IN((k) + 1)) xcd_barrier(bar); } while (0)

    if (IN(PH_P0)) { PH_BEGIN; p0_prologue(P, lds, vcu, G, gw, NGW, wave, lane); } SEAM(PH_P0);

    if (IN(PH_NORM1)) { PH_BEGIN;
        bf16* A = (bf16*)(ar + AR_A);
        const int per = (MT + NGW - 1) / NGW, T1 = (gw + 1) * per < MT ? (gw + 1) * per : MT; int rcur = -1; f32x4 gg[8], s0[8];
        for (int T = gw * per; T < T1; ++T) { int b, p, r; row_info(T, b, p, r);
            if (r != rcur) { const float* m = mod + (size_t)r * NMOD; mod_load(P->in[I_N1G], m, m + DM, lane, gg, s0); rcur = r; }
            const float* src = p < CTXL ? P->in[I_CTX] + ((size_t)b * CTXL + p) * DM : P->in[I_X] + ((size_t)b * SEQ + (p - CTXL)) * DM;
            f32x4 v[8]; row_load(src, lane, v); norm_apply(v, gg, s0, lane, nullptr, (unsigned char*)A + (size_t)T * DM); }
    } SEAM(PH_NORM1);
    if (IN(PH_DOWN)) { PH_BEGIN;
        DenseSched S{(const char*)(ws + WS_BT_DOWN), (size_t)256 * 2048, NPAN, 6, G, bx, 0, 0};
        EpiDown E{(unsigned char*)(ar + AR_DOWN), ssq};
        pg8::gemm_phase<EpiDown, DenseSched, true>(wave, lds, (const char*)(ar + AR_A), DM, DM, S, E);
    } SEAM(PH_DOWN);
    if (IN(PH_UP)) { PH_BEGIN;
        { DenseSched S{(const char*)(ws + WS_BT_UQ), (size_t)256 * 768, NPAN, 12, G, bx, 0, 0};
          EpiScaleBf16 E{(bf16*)(ar + AR_QRAW), 3072, nullptr, 0, 0, 1.f / W2_SCALE, 1.f};
          pg8::gemm_phase<EpiScaleBf16, DenseSched, true>(wave, lds, (const char*)(ar + AR_DOWN), 1536, 768, S, E); }
        { DenseSched S{(const char*)(ws + WS_BT_UKV), (size_t)256 * 512, NPAN, 16, G, (bx + G / 2) % G, 0, 0};
          EpiKV E{(bf16*)(ar + AR_KVRAW), (unsigned char*)(ar + AR_KF), (const unsigned char*)(ar + AR_DOWN), ssq, P->in[I_MLA_GKN], lds};
          pg8::gemm_phase<EpiKV, DenseSched, true>(wave, lds, (const char*)(ar + AR_DOWN) + 768, 1536, 512, S, E); }
    } SEAM(PH_UP);
    if (IN(PH_ATT0)) { PH_BEGIN;
        const bf16* QF = (const bf16*)(ar + AR_QRAW); const bf16* KF = (const bf16*)(ar + AR_KF); const bf16* KV = (const bf16*)(ar + AR_KVRAW); unsigned char* O = (unsigned char*)(ar + AR_O);
        const float scale = 0.07216878364870322f;
        const int slot = (bx >> 3) % 5;     int ui = 0;
        for (int u = vcu; u < 1024 + 128 || ui <= slot; u += G, ++ui) {
            if (ui == slot) { __syncthreads(); cvt_moe_blocks(P, (LAS float*)lds, 0, vcu, G, tid); __syncthreads(); }
            if (u >= 1024 + 128) continue;
            int b, h, q0, seq;
            if (u < 1024) { b = u >> 7; h = (u >> 3) & 15; q0 = CTXL + (u & 7) * 256; seq = TPB; } else { const int j = u - 1024; b = j >> 4; h = j & 15; q0 = 0; seq = CTXL; }
            const size_t rb = (size_t)b * TPB;
            att::attn_body8<192, 3072, 3072, 4096, 2048>(wave, QF + (rb + q0) * 3072 + h * 192, (const unsigned char*)KF + rb * 3072 + h * 192, KV + rb * 4096 + h * 256 + 128, O + (rb + q0) * 2048 + h * 128, seq, scale, P->in[I_MLA_GQN], q0 - CTXL, (char*)lds_raw);
        }
    } SEAM(PH_ATT0);
    if (IN(PH_WO0)) { PH_BEGIN;
        DenseSched S{(const char*)(ws + WS_BT_WO0), (size_t)256 * 2048, NPAN, 8, G, bx, 0, 0};
        EpiResid E{P->in[I_X], P->in[I_CTX], nullptr, hbuf, mod, 2 * DM, 1, 1.f / (W1_SCALE * O_SCALE)};
        pg8::gemm_phase<EpiResid, DenseSched, true>(wave, lds, (const char*)(ar + AR_O), DM, DM, S, E);
    } SEAM(PH_WO0);
    if (IN(PH_NORM2_0)) { PH_BEGIN;
        bf16* F = (bf16*)(ar + AR_A);
        const int per = (MT + NGW - 1) / NGW, T1 = (gw + 1) * per < MT ? (gw + 1) * per : MT; int rcur = -1; f32x4 gg[8], s0[8];
        for (int T = gw * per; T < T1; ++T) { int b, p, r; row_info(T, b, p, r);
            if (r != rcur) { const float* m = mod + (size_t)r * NMOD; mod_load(P->in[I_N2G], m + 3 * DM, m + 4 * DM, lane, gg, s0); rcur = r; }
            f32x4 v[8]; row_load_bf(hbuf + (size_t)T * DM, lane, v); norm_apply(v, gg, s0, lane, F + (size_t)T * DM, (unsigned char*)(ws + WS_F8) + (size_t)T * DM); }
    } SEAM(PH_NORM2_0);
    if (IN(PH_ROUTER0)) { PH_BEGIN;
        { RouterSched S{(const char*)(ws + WS_BT_R), NPAN, G, vcu, 0};
          EpiRouter E{(float*)(ar + AR_LOGIT4)};
          pg8::gemm_phase(wave, lds, (const char*)(ar + AR_A), DM * 2, DM * 2, S, E, 8); }
        { PanelSched S{(const char*)(ws + WS_BT_S1), (size_t)256 * 2048, NPAN - 8, 4, G, vcu, 0, 8};
          EpiActS E{(unsigned char*)(ws + WS_ACT + ACT_S_OFF)};
          pg8::gemm_phase<EpiActS, PanelSched, true>(wave, lds, (const char*)(ws + WS_F8), DM, DM, S, E); }
    } SEAM(PH_ROUTER0);
    if (IN(PH_TOPK0)) { PH_BEGIN; if (vcu == 0) for (int i = tid; i < 2048; i += NTHREADS) { ((int*)(ws + WS_IDENT))[i] = i; ((float*)(ws + WS_IDENT + (size_t)NEXP * CAP * 4))[i] = ACT_SCALE / ACT_SCALE_R; }
        route_phase<false>(P, 0, lds, MT, vcu, G, wave, lane, tid); } SEAM(PH_TOPK0);
    if (IN(PH_G1_0)) { PH_BEGIN;
        const int* cnt = (const int*)ctl + CW_CNT; moe_prefix(cnt, ublk, tid);
        { MoeSched<true> S{(const float*)(ws + WS_WLIST), ublk, cnt, (const int*)(ws + WS_LIST), (const char*)(ws + WS_MOE1), (size_t)1024 * 2048, (const char*)(ws + WS_BT_S1), (size_t)256 * 2048, 4, 8, 0, G, vcu};
          EpiAct E{(unsigned char*)(ws + WS_ACT), lds, (unsigned char*)(ws + WS_ACT + ACT_S_OFF)};
          pg8::gemm_phase<EpiAct, MoeSched<true>, true>(wave, lds, (const char*)(ws + WS_F8), DM, DM, S, E); }
    } SEAM(PH_G1_0);
    if (IN(PH_G2_0)) { PH_BEGIN;
        const int* cnt = (const int*)ctl + CW_CNT; moe_prefix(cnt, ublk, tid);
        { MoeSched<false> S{nullptr, ublk, cnt, nullptr, (const char*)(ws + WS_MOE2), (size_t)2048 * 512, (const char*)(ws + WS_MOE2), (size_t)256 * 512, 8, 0, 0, G, vcu};
          EpiY E{(unsigned char*)(ar + AR_Y), Y_SCALE / (ACT_SCALE_R * W2_SCALE)};
          pg8::gemm_phase<EpiY, MoeSched<false>, true>(wave, lds, (const char*)(ws + WS_ACT), DEXP, DEXP, S, E); }
        { DenseSched S{(const char*)(ws + WS_BT_S2), (size_t)256 * 512, NPAN, 8, G, (bx + G / 2) % G, 0, 0};
          EpiY E{(unsigned char*)(ar + AR_YS), Y_SCALE / (ACT_SCALE * W2_SCALE)};
          pg8::gemm_phase<EpiY, DenseSched, true>(wave, lds, (const char*)(ws + WS_ACT + ACT_S_OFF), DEXP, DEXP, S, E); }
    } SEAM(PH_G2_0);
    if (IN(PH_COMB0)) { PH_BEGIN;
        const int* cnt = (const int*)ctl + CW_CNT; moe_prefix(cnt, ublk, tid);
        const int tot = ublk[64];
        const int per = (MT + NGW - 1) / NGW, T1 = (gw + 1) * per < MT ? (gw + 1) * per : MT; int rcur = -1; float gtv[4][8], gg1[4][8], s01[4][8];
        for (int T = gw * per; T < T1; ++T) { int b, p, r; row_info(T, b, p, r); if (r != rcur) { comb_mod_load(P, 0, r, lane, gtv, gg1, s01); rcur = r; }
            combine_row(P, 0, T, tot + (T >> 8), ublk, lane, gtv, gg1, s01); }
    } SEAM(PH_COMB0);

    if (IN(PH_QKV)) { PH_BEGIN;
        DenseSched S{(const char*)(ws + WS_BT_QKV), (size_t)256 * 2048, NPAN_LAT, 12, G, bx, 1, 32};
        EpiQKV1 E{(bf16*)(ar + AR_QRAW), (unsigned char*)(ar + AR_KF), P->in[I_GQA_GKN], lds};
        pg8::gemm_phase<EpiQKV1, DenseSched, true>(wave, lds, (const char*)(ws + WS_ACT), DM, DM, S, E);
    } SEAM(PH_QKV);
    if (IN(PH_ATT1)) { PH_BEGIN;
        const bf16* QF = (const bf16*)(ar + AR_QF); const bf16* KF = (const bf16*)(ar + AR_KF); const bf16* RAW = (const bf16*)(ar + AR_QRAW); unsigned char* O = (unsigned char*)(ar + AR_O);
        const float scale = 0.08838834764831845f;
        const int slot = (bx >> 3) % 5;     int ui = 0;
        for (int u = vcu; u < 1024 || ui <= slot; u += G, ++ui) {
            if (ui == slot) { __syncthreads(); cvt_moe_blocks(P, (LAS float*)lds, 1, vcu, G, tid); __syncthreads(); }
            if (u >= 1024) continue;
            const int b = u >> 7, h = (u >> 3) & 15, q0 = CTXL + (u & 7) * 256, kvh = h >> 2; const size_t rb = (size_t)b * TPB;
            att::attn_body8<128, 3072, 512, 3072, 2048>(wave, RAW + (rb + q0) * 3072 + h * 128, (const unsigned char*)KF + rb * 512 + kvh * 128, RAW + rb * 3072 + 2560 + kvh * 128, O + (rb + q0) * 2048 + h * 128, TPB, scale, P->in[I_GQA_GQN], q0 - CTXL, (char*)lds_raw);
        }
    } SEAM(PH_ATT1);
    if (IN(PH_WO1)) { PH_BEGIN;
        DenseSched S{(const char*)(ws + WS_BT_WO1), (size_t)256 * 2048, NPAN_LAT, 8, G, bx, 1, 0};
        EpiResid E{nullptr, nullptr, hbuf, hbuf, mod + (size_t)9 * NMOD, 2 * DM, 0, 1.f / (W1_SCALE * O_SCALE)};
        pg8::gemm_phase<EpiResid, DenseSched, true>(wave, lds, (const char*)(ar + AR_O), DM, DM, S, E);
    } SEAM(PH_WO1);
    if (IN(PH_NORM2_1)) { PH_BEGIN;
        bf16* F = (bf16*)(ar + AR_A);
        const int per = (NBATCH * SEQ + NGW - 1) / NGW, j1 = (gw + 1) * per < NBATCH * SEQ ? (gw + 1) * per : NBATCH * SEQ; int rcur = -1; f32x4 gg[8], s0[8];
        for (int j = gw * per; j < j1; ++j) { const int b = j >> 11, T = b * TPB + CTXL + (j & 2047);
            if (b != rcur) { const float* m = mod + (size_t)(9 + b) * NMOD; mod_load(P->in[I_N2G] + DM, m + 3 * DM, m + 4 * DM, lane, gg, s0); rcur = b; }
            f32x4 v[8]; row_load_bf(hbuf + (size_t)T * DM, lane, v); norm_apply(v, gg, s0, lane, F + (size_t)T * DM, (unsigned char*)(ws + WS_F8) + (size_t)T * DM); }
    } SEAM(PH_NORM2_1);
    if (IN(PH_ROUTER1)) { PH_BEGIN;
        { RouterSched S{(const char*)(ws + WS_BT_R) + (size_t)256 * 2048 * 2, NPAN_LAT, G, vcu, 1};
          EpiRouter E{(float*)(ar + AR_LOGIT4)};
          pg8::gemm_phase(wave, lds, (const char*)(ar + AR_A), DM * 2, DM * 2, S, E, 8); }
        { PanelSched S{(const char*)(ws + WS_BT_S1) + (size_t)1024 * 2048, (size_t)256 * 2048, NPAN_LAT, 4, G, vcu, 1};
          EpiActS E{(unsigned char*)(ws + WS_ACT + ACT_S_OFF)};
          pg8::gemm_phase<EpiActS, PanelSched, true>(wave, lds, (const char*)(ws + WS_F8), DM, DM, S, E); }
    } SEAM(PH_ROUTER1);
    if (IN(PH_TOPK1)) { PH_BEGIN; route_phase<true>(P, 1, lds, NBATCH * SEQ, vcu, G, wave, lane, tid); } SEAM(PH_TOPK1);
    if (IN(PH_G1_1)) { PH_BEGIN;
        const int* cnt = (const int*)ctl + CW_CNT + 64 * CNT_STRIDE; moe_prefix(cnt, ublk, tid);
        { MoeSched<true> S{(const float*)(ws + WS_WLIST), ublk, cnt, (const int*)(ws + WS_LIST), (const char*)(ws + WS_MOE1) + (size_t)64 * 1024 * 2048, (size_t)1024 * 2048, (const char*)(ws + WS_MOE1), (size_t)256 * 2048, 4, 0, 1, G, vcu};
          EpiAct E{(unsigned char*)(ws + WS_ACT), lds};
          pg8::gemm_phase<EpiAct, MoeSched<true>, true>(wave, lds, (const char*)(ws + WS_F8), DM, DM, S, E); }
    } SEAM(PH_G1_1);
    if (IN(PH_G2_1)) { PH_BEGIN;
        const int* cnt = (const int*)ctl + CW_CNT + 64 * CNT_STRIDE; moe_prefix(cnt, ublk, tid);
        { MoeSched<false> S{nullptr, ublk, cnt, nullptr, (const char*)(ws + WS_MOE2) + (size_t)64 * 2048 * 512, (size_t)2048 * 512, (const char*)(ws + WS_MOE2), (size_t)256 * 512, 8, 0, 1, G, vcu};
          EpiY E{(unsigned char*)(ar + AR_Y), Y_SCALE / (ACT_SCALE_R * W2_SCALE)};
          pg8::gemm_phase<EpiY, MoeSched<false>, true>(wave, lds, (const char*)(ws + WS_ACT), DEXP, DEXP, S, E); }
        { DenseSched S{(const char*)(ws + WS_BT_S2) + (size_t)2048 * 512, (size_t)256 * 512, NPAN_LAT, 8, G, (bx + G / 2) % G, 1, 0};
          EpiY E{(unsigned char*)(ar + AR_YS), Y_SCALE / (ACT_SCALE * W2_SCALE)};
          pg8::gemm_phase<EpiY, DenseSched, true>(wave, lds, (const char*)(ws + WS_ACT + ACT_S_OFF), DEXP, DEXP, S, E); }
    } SEAM(PH_G2_1);
    if (IN(PH_COMB1)) { PH_BEGIN;
        const int* cnt = (const int*)ctl + CW_CNT + 64 * CNT_STRIDE; moe_prefix(cnt, ublk, tid);
        const int tot = ublk[64];
        const int per = (NBATCH * SEQ + NGW - 1) / NGW, j1 = (gw + 1) * per < NBATCH * SEQ ? (gw + 1) * per : NBATCH * SEQ; int rcur = -1; float gtv[4][8], gg1[4][8], s01[4][8];
        for (int j = gw * per; j < j1; ++j) { const int b = j >> 11, T = b * TPB + CTXL + (j & 2047); if (b != rcur) { comb_mod_load(P, 1, b, lane, gtv, gg1, s01); rcur = b; }
            combine_row(P, 1, T, tot + (j >> 8), ublk, lane, gtv, gg1, s01); }
    }
#undef IN
#undef SEAM
}

extern "C" void kernel_launch(void* const* d_in, const int* in_sizes, int n_in, void* d_out, int out_size, void* d_ws, size_t ws_size, hipStream_t stream) {
    static int grid = 0;
    if (grid == 0) {
        if (n_in != 28 || ws_size < WS_END) { fprintf(stderr, "kernel_launch: expected 28 inputs and >= %zu bytes of workspace; got %d, %zu\n", (size_t)WS_END, n_in, ws_size); grid = -1; return; }
        int dev = 0, cus = 0, per_cu = 0;
        if (hipGetDevice(&dev) != hipSuccess || hipDeviceGetAttribute(&cus, hipDeviceAttributeMultiprocessorCount, dev) != hipSuccess) { grid = -1; return; }
        if (hipFuncSetAttribute((const void*)mega_fwd, hipFuncAttributeMaxDynamicSharedMemorySize, LDS_BYTES) != hipSuccess) { fprintf(stderr, "kernel_launch: hipFuncSetAttribute failed\n"); grid = -1; return; }
        if (hipOccupancyMaxActiveBlocksPerMultiprocessor(&per_cu, (const void*)mega_fwd, NTHREADS, LDS_BYTES) != hipSuccess || per_cu < 1) { fprintf(stderr, "kernel_launch: occupancy query reports %d\n", per_cu); }
        (void)hipGetLastError();
        grid = cus;
    }
    if (grid < 0) return;
    (void)hipMemsetAsync((char*)d_ws + WS_CTL, 0, CTL_BYTES, stream);
    Params p{};
    for (int i = 0; i < 28; ++i) p.in[i] = (const float*)d_in[i];
    p.out = (float*)d_out; p.ws = (unsigned char*)d_ws;
#if MK_PER_PHASE
    for (int ph = 0; ph < PH_COUNT; ++ph) { p.ph_lo = ph; p.ph_hi = ph + 1; hipLaunchKernelGGL(mega_fwd, dim3(grid), dim3(NTHREADS), LDS_BYTES, stream, p); }
#else
    p.ph_lo = 0; p.ph_hi = PH_COUNT;
    hipLaunchKernelGGL(mega_fwd, dim3(grid), dim3(NTHREADS), LDS_BYTES, stream, p);
#endif
    const hipError_t le = hipPeekAtLastError();
    if (le != hipSuccess) fprintf(stderr, "kernel_launch: launch failed: %s\n", hipGetErrorName(le));
}
```

```cpp
#include <hip/hip_runtime.h>
#include <cstdio>
#include <cstdint>

#ifndef MK_PER_PHASE
#define MK_PER_PHASE 0
#endif

#define LAS __attribute__((address_space(3)))
typedef unsigned short bf16;
typedef short bf16x8 __attribute__((ext_vector_type(8)));
typedef short s16x4 __attribute__((ext_vector_type(4)));
typedef float f32x4 __attribute__((ext_vector_type(4)));
typedef float f32x16 __attribute__((ext_vector_type(16)));
typedef float f32x2 __attribute__((ext_vector_type(2)));
typedef unsigned u32x4 __attribute__((ext_vector_type(4)));
typedef unsigned u32x2 __attribute__((ext_vector_type(2)));
typedef int v4i32 __attribute__((ext_vector_type(4)));
typedef int v8i32 __attribute__((ext_vector_type(8)));

constexpr int DM = 2048, NBATCH = 8, SEQ = 2048, CTXL = 256, TPB = SEQ + CTXL  , MT = NBATCH * TPB  ;
constexpr int NPAN = MT / 256  , NPAN_LAT = NBATCH * SEQ / 256  ;
constexpr int NMOD = 6 * DM;
constexpr int NEXP = 64, TOPK = 8, DEXP = 512;
constexpr int CAP = MT;
constexpr int MAXBLK = MT * TOPK / 256 + NEXP + NPAN;
constexpr float EPS = 1e-6f;
constexpr int NWAVES = 8, NTHREADS = 512;

constexpr size_t MiB = 1u << 20;
constexpr size_t WS_CTL = 0, CTL_BYTES = 2 * MiB;
constexpr int CW_BAR = 1024;
constexpr int CW_CNT = 8192, CNT_STRIDE = 64;
constexpr size_t CTL_MOD = 64 * 1024;
constexpr size_t WS_BT_DOWN = 2 * MiB;
constexpr size_t WS_BT_UQ = WS_BT_DOWN + (size_t)1536 * 2048 * 2;
constexpr size_t WS_BT_UKV = WS_BT_UQ + (size_t)3072 * 768 * 2;
constexpr size_t WS_BT_WO0 = WS_BT_UKV + (size_t)4096 * 512 * 2;
constexpr size_t WS_BT_QKV = WS_BT_WO0 + (size_t)2048 * 2048 * 2;
constexpr size_t WS_BT_WO1 = WS_BT_QKV + (size_t)3072 * 2048 * 2;
constexpr size_t WS_BT_S1 = WS_BT_WO1 + (size_t)2048 * 2048 * 2;
constexpr size_t WS_BT_S2 = WS_BT_S1 + (size_t)2 * 1024 * 2048 * 2;
constexpr size_t WS_BT_R = WS_BT_S2 + (size_t)2 * 2048 * 512 * 2;
constexpr size_t WS_SMALL_END = WS_BT_R + (size_t)2 * 256 * 2048 * 2;
static_assert(WS_SMALL_END <= 64 * MiB, "small weights");
constexpr size_t WS_MOE1 = 64 * MiB;
constexpr size_t WS_F8 = 320 * MiB;
constexpr size_t WS_MOE2 = 576 * MiB;
constexpr float W1_SCALE = 64.f, W2_SCALE = 32.f, ACT_SCALE = 8.f, ACT_SCALE_R = 16.f, Y_SCALE = 32.f, O_SCALE = 8.f;
constexpr size_t WS_H = 832 * MiB;
constexpr size_t WS_ACT = 976 * MiB;
constexpr size_t WS_LOGIT = 1156 * MiB;
constexpr size_t WS_LIST = WS_LOGIT + (size_t)MT * 64 * 4;
constexpr size_t WS_WLIST = WS_LIST + (size_t)NEXP * CAP * 4;
constexpr size_t WS_IDENT = 400 * MiB;
constexpr int IDENT_OFF = (int)(((long long)WS_IDENT - (long long)WS_LIST) / 4);
constexpr size_t WS_ASG = WS_WLIST + (size_t)NEXP * CAP * 4;
constexpr size_t WS_SSQP = WS_ASG + (size_t)MT * 8 * 4;
static_assert(WS_SSQP + (size_t)MT * 24 * 4 <= 1176 * MiB, "misc");
constexpr size_t WS_ARENA = 1176 * MiB;
constexpr size_t AR_A = 0;
constexpr size_t AR_DOWN = 72 * MiB;
constexpr size_t AR_QRAW = 126 * MiB;
constexpr size_t AR_KVRAW = 234 * MiB;
constexpr size_t AR_QF = 378 * MiB;
constexpr size_t AR_KF = 486 * MiB;
constexpr size_t AR_LOGIT4 = 378 * MiB;
constexpr size_t AR_O = 594 * MiB;
constexpr size_t AR_Y = 0;
constexpr size_t AR_YS = 400 * MiB;
constexpr size_t ACT_S_OFF = 96 * MiB;
constexpr size_t WS_END = WS_ARENA + (size_t)MAXBLK * 256 * 2048 * 2;
static_assert(WS_END <= 2048 * MiB, "workspace");

constexpr int LDS_MISC = 136 * 1024;
constexpr int LDS_BYTES = 144 * 1024;

__device__ __forceinline__ unsigned cvt_pk_bf16(float lo, float hi) { unsigned r; asm volatile("v_cvt_pk_bf16_f32 %0, %1, %2" : "=v"(r) : "v"(lo), "v"(hi)); return r; }
__device__ __forceinline__ float bf_lo(unsigned w) { return __uint_as_float(w << 16); }
__device__ __forceinline__ float bf_hi(unsigned w) { return __uint_as_float(w & 0xffff0000u); }
__device__ __forceinline__ float wave_sum(float v) {
#pragma unroll
    for (int o = 1; o < 64; o <<= 1) v += __shfl_xor(v, o);
    return v;
}
__device__ __forceinline__ int lane_id() { return (int)__builtin_amdgcn_mbcnt_hi(~0u, __builtin_amdgcn_mbcnt_lo(~0u, 0u)); }
#define LDS_WAIT() asm volatile("s_waitcnt lgkmcnt(0)" ::: "memory")
#define VM_WAIT() asm volatile("s_waitcnt vmcnt(0)" ::: "memory")

#define XB_TMO      128
#define XB_XCNT(j)  (256  + 64 * (j))
#define XB_XSUB(j)  (1280 + 64 * (j))
#define XB_XGEN(j)  (2304 + 64 * (j))
#define XB_TOP      3328
#define XB_TOPGEN   3392
#define XCD_BAR_WORDS 3456
#define XB_SPIN_CAP (1u << 18)
__device__ __forceinline__ unsigned xb_ld(unsigned* p)              { return __hip_atomic_load(p, __ATOMIC_RELAXED, __HIP_MEMORY_SCOPE_AGENT); }
__device__ __forceinline__ unsigned xb_add(unsigned* p, unsigned v) { return __hip_atomic_fetch_add(p, v, __ATOMIC_RELAXED, __HIP_MEMORY_SCOPE_AGENT); }
__device__ __forceinline__ unsigned xb_xcc_id() { return (unsigned)__builtin_amdgcn_s_getreg((3 << 11) | 20) & 0xFu; }
#define XB_SPIN(cond, bar) do { unsigned _sp = 0; while (cond) { __builtin_amdgcn_s_sleep(1); \
    if ((++_sp & 255u) == 0u) { if (xb_ld(&(bar)[XB_TMO])) break; if (_sp > XB_SPIN_CAP) { atomicAdd(&(bar)[XB_TMO], 1u); break; } } } } while (0)
struct XcdBarrier { unsigned* bar; unsigned x; volatile LAS unsigned* st; int wave; };
__device__ __forceinline__ XcdBarrier xcd_barrier_post(unsigned* bar, volatile LAS unsigned* st, int wave) {
    XcdBarrier b; b.bar = bar; b.x = xb_xcc_id(); b.st = st; b.wave = wave;
    if (wave == 0 && lane_id() == 0) (void)xb_add(&bar[XB_XCNT(b.x)], 1u);
    return b;
}
__device__ __forceinline__ void xcd_barrier_complete(unsigned* bar, unsigned x, unsigned& nloc, unsigned& nx) {
    const unsigned G = gridDim.x * gridDim.y * gridDim.z;
    unsigned sum, cnt, mine, sp = 0u;
    for (;;) {
        sum = 0u; cnt = 0u; mine = 0u;
#pragma unroll
        for (unsigned j = 0; j < 16; ++j) { const unsigned c = xb_ld(&bar[XB_XCNT(j)]); sum += c; cnt += (c > 0u) ? 1u : 0u; mine = (j == x) ? c : mine; }
        if (sum == G) break;
        __builtin_amdgcn_s_sleep(1);
        if ((++sp & 255u) == 0u) { if (xb_ld(&bar[XB_TMO])) break; if (sp > XB_SPIN_CAP) { atomicAdd(&bar[XB_TMO], 1u); break; } }
    }
    nloc = mine > 0u ? mine : 1u; nx = cnt > 0u ? cnt : 1u;
}
__device__ __forceinline__ void xcd_barrier(const XcdBarrier& b) {
    asm volatile("s_waitcnt vmcnt(0)" ::: "memory");
    __syncthreads();
    if (b.wave == 0 && lane_id() == 0) {
        unsigned* bar = b.bar;
        __builtin_amdgcn_s_waitcnt(0);
        unsigned nloc = b.st[0], nx = b.st[1];
        if (nloc == 0u) { xcd_barrier_complete(bar, b.x, nloc, nx); b.st[0] = nloc; b.st[1] = nx; }
        const unsigned old = xb_add(&bar[XB_XSUB(b.x)], 1u);
        const unsigned gen = old / nloc;
        if (old + 1u == (gen + 1u) * nloc) {
            __builtin_amdgcn_fence(__ATOMIC_RELEASE, "agent");
            asm volatile("s_waitcnt vmcnt(0)" ::: "memory");
            const unsigned og = xb_add(&bar[XB_TOP], 1u);
            const unsigned tg = og / nx;
            if (og + 1u == (tg + 1u) * nx) xb_add(&bar[XB_TOPGEN], 1u);
            else XB_SPIN(xb_ld(&bar[XB_TOPGEN]) == tg, bar);
            __builtin_amdgcn_fence(__ATOMIC_ACQUIRE, "agent");
            xb_add(&bar[XB_XGEN(b.x)], 1u);
            asm volatile("s_waitcnt vmcnt(0)" ::: "memory");
        } else {
            XB_SPIN(xb_ld(&bar[XB_XGEN(b.x)]) == gen, bar);
            __builtin_amdgcn_fence(__ATOMIC_ACQUIRE, "agent");
            asm volatile("s_waitcnt vmcnt(0)" ::: "memory");
        }
    }
    __syncthreads();
}

namespace pg8 {
constexpr int BM = 256, BK = 64, HALF = 128, HTB = HALF * BK * 2, STAGE_BYTES = 8 * HTB, NXCD = 8, WGM = 8;
__host__ __device__ __forceinline__ int lds_byte(int r, int c) { const int st = (r >> 4) * 2 + (c >> 5), rr = r & 15, cc = c & 31, ob = rr * 64 + cc * 2; return st * 1024 + (ob ^ (((ob >> 9) & 1) << 5)); }
__host__ __device__ __forceinline__ void stage_rc(int b, int& R, int& C) { const int st = b / 1024, sb = b % 1024, swz = sb ^ (((sb >> 9) & 1) << 5); R = (st >> 1) * 16 + swz / 64; C = (st & 1) * 32 + (swz % 64) / 2; }
__host__ __device__ __forceinline__ int f8g(int rr) { return ((rr >> 2) ^ (rr >> 3)) & 1; }
__host__ __device__ __forceinline__ int lds_byte_f8(int r, int cb) { const int st = (r >> 4) * 2 + (cb >> 6), rr = r & 15; int ob = rr * 64 + (cb & 63); ob ^= ((ob >> 9) & 1) << 5; ob ^= f8g(rr) << 4; return st * 1024 + ob; }
__host__ __device__ __forceinline__ void stage_rc_f8(int b, int& R, int& C) { const int st = b / 1024, sb = b % 1024, rr = sb >> 6, sb1 = sb ^ (f8g(rr) << 4), sb2 = sb1 ^ (((sb1 >> 9) & 1) << 5); R = (st >> 1) * 16 + sb2 / 64; C = ((st & 1) * 64 + (sb2 % 64)) / 2; }
__host__ __device__ __forceinline__ int perm32(int rho) { const int n = rho >> 4, i = rho & 15; return 8 * (i >> 2) + 4 * n + (i & 3); }

struct Unit {
    const char* Bp;
    int arow0;
    int alim;
    int orow0;
    int pn;
    int e;
    int koff;
    int auxoff;
};

__device__ __forceinline__ bool static_tile(int L, int nM, int nN, int& pm, int& pn) {
    const int nwg = nM * nN; if (L >= nwg) return false;
    int wgid = L; { const int q = nwg / NXCD, r = nwg % NXCD, xcd = wgid % NXCD, off = wgid / NXCD; wgid = (xcd < r ? xcd * (q + 1) : r * (q + 1) + (xcd - r) * q) + off; }
    const int nig = WGM * nN, gid = wgid / nig, fm = gid * WGM, gsz = (nM - fm) < WGM ? (nM - fm) : WGM;
    pm = fm + ((wgid % nig) % gsz); pn = (wgid % nig) / gsz; return true;
}

template <bool FP8> struct Frag;
template <> struct Frag<false> { bf16x8 k[2]; };
template <> struct Frag<true> { v8i32 v; };
template <class Epi, class Sched, bool FP8 = false>
__device__ __forceinline__ void gemm_phase(const int wid, LAS unsigned char* lds, const char* Abase, const int ldab, const int Kb, const Sched& S, const Epi& E, const int ktiles = 0) {
    int lane_ = lane_id(); asm volatile("" : "+v"(lane_));
    const int lane = lane_, tid = wid * 64 + lane, wr = wid >> 2, wc = wid & 3, fr = lane & 15, fq = lane >> 4;
    const int nt = ktiles ? ktiles : Kb / 128;
    int Rr[2], Cc[2]; unsigned voffB[2];
#pragma unroll
    for (int i = 0; i < 2; ++i) { if constexpr (FP8) stage_rc_f8(tid * 16 + i * 8192, Rr[i], Cc[i]); else stage_rc(tid * 16 + i * 8192, Rr[i], Cc[i]); const int ii_ = Rr[i] & 15; const int Rb = Epi::PERM ? (64 * (Rr[i] >> 5) + 16 * (ii_ >> 2) + 4 * ((Rr[i] >> 4) & 1) + (ii_ & 3)) : Rr[i]; voffB[i] = (unsigned)(Rb * Kb + Cc[i] * 2); }
    const size_t kstep = (size_t)(BK * 2);
    const size_t hstepB = Epi::PERM ? (size_t)8 * Kb : (size_t)HALF * Kb;
    const unsigned ldsw = (unsigned)wid * 1024u;
    const int aoff = FP8 ? lds_byte_f8(wr * 64 + fr, fq * 32) : lds_byte(wr * 64 + fr, fq * 8), boff = FP8 ? lds_byte_f8(wc * 32 + fr, fq * 32) : lds_byte(wc * 32 + fr, fq * 8);
    const int aoff2 = aoff ^ 16, boff2 = boff ^ 16;
    unsigned la0 = (unsigned)(size_t)lds + aoff, la1 = (unsigned)(size_t)lds + aoff2, lb0 = (unsigned)(size_t)lds + 65536u + boff, lb1 = (unsigned)(size_t)lds + 65536u + boff2;
    asm volatile("" : "+v"(la0), "+v"(la1), "+v"(lb0), "+v"(lb1));
#define PG8_SA(b, h) (((b) * 2 + (h)) * HTB)
#define PG8_SB(b, h) ((4 + (b) * 2 + (h)) * HTB)
#define PG8_STAGE(bufoff, gbase, v0, v1) do { \
        __builtin_amdgcn_global_load_lds((const unsigned*)((const char*)(gbase) + (v0)), (LAS unsigned*)(lds + (bufoff) + ldsw), 16, 0, 0); \
        __builtin_amdgcn_global_load_lds((const unsigned*)((const char*)(gbase) + (v1)), (LAS unsigned*)(lds + (bufoff) + ldsw + 8192), 16, 0, 0); } while (0)
#define PG8_LDF(dst, base_, o1_, o2_) do { if constexpr (FP8) (dst).v = __builtin_shufflevector(*(const LAS v4i32*)(size_t)((o1_) + (unsigned)(base_)), *(const LAS v4i32*)(size_t)((o2_) + (unsigned)(base_)), 0, 1, 2, 3, 4, 5, 6, 7); \
        else { (dst).k[0] = *(const LAS bf16x8*)(size_t)((o1_) + (unsigned)(base_)); (dst).k[1] = *(const LAS bf16x8*)(size_t)((o1_) + (unsigned)(base_) + 1024u); } } while (0)
#define PG8_LDA(dst, b, h) do { _Pragma("unroll") for (int m = 0; m < 4; ++m) PG8_LDF(dst[m], PG8_SA(b, h) + m * 2048, la0, la1); } while (0)
#define PG8_LDB(dst, b, h) do { _Pragma("unroll") for (int n = 0; n < 2; ++n) PG8_LDF(dst[n], PG8_SB(b, h) - 65536 + n * 2048, lb0, lb1); } while (0)
#define PG8_MMA(ai, bj, At, Bt) do { __builtin_amdgcn_s_setprio(1); _Pragma("unroll") for (int m = 0; m < 4; ++m) _Pragma("unroll") for (int n = 0; n < 2; ++n) { \
        if constexpr (FP8) acc[ai][bj][m][n] = __builtin_amdgcn_mfma_scale_f32_16x16x128_f8f6f4(Bt[n].v, At[m].v, acc[ai][bj][m][n], 0, 0, 0, 0, 0, 0); \
        else { _Pragma("unroll") for (int k = 0; k < 2; ++k) acc[ai][bj][m][n] = __builtin_amdgcn_mfma_f32_16x16x32_bf16(Bt[n].k[k], At[m].k[k], acc[ai][bj][m][n], 0, 0, 0); } } \
        __builtin_amdgcn_s_setprio(0); } while (0)
#define PG8_WAIT_V(n) asm volatile("s_waitcnt vmcnt(" #n ")" ::: "memory")
#define PG8_WAIT_L(n) asm volatile("s_waitcnt lgkmcnt(" #n ")" ::: "memory")
#define PG8_BAR __builtin_amdgcn_s_barrier()
#define PG8_SCHED __builtin_amdgcn_sched_barrier(0)
#define PG8_AOFFS(dst, u) do { _Pragma("unroll") for (int h = 0; h < 2; ++h) _Pragma("unroll") for (int i = 0; i < 2; ++i) \
        dst[h][i] = (unsigned)(S.arow((u), h * HALF + Rr[i]) * ldab + Cc[i] * 2 + (u).koff); } while (0)
    Unit cur, nxt; int ui = 0;
    if (!S.next(0, cur)) return;
    constexpr int AUX_OFF = LDS_MISC + 2048;
    cur.auxoff = 0;
    if constexpr (Sched::AUX) __builtin_amdgcn_global_load_lds(S.aux_src(cur, wid, lane), (LAS unsigned*)(lds + AUX_OFF + wid * 256), 4, 0, 0);
    f32x4 acc[2][2][4][2];
#pragma unroll
    for (int a = 0; a < 2; ++a)
#pragma unroll
        for (int b = 0; b < 2; ++b)
#pragma unroll
            for (int m = 0; m < 4; ++m)
#pragma unroll
                for (int n = 0; n < 2; ++n) acc[a][b][m][n] = (f32x4){0.f, 0.f, 0.f, 0.f};
    Frag<FP8> At[4], B0[2], B1[2];
    unsigned aoC[2][2], aoN[2][2];
    PG8_AOFFS(aoC, cur);
    const char* cB = cur.Bp;
    PG8_STAGE(PG8_SB(0, 0), cB, voffB[0], voffB[1]); PG8_STAGE(PG8_SA(0, 0), Abase, aoC[0][0], aoC[0][1]);
    PG8_STAGE(PG8_SB(0, 1), cB + hstepB, voffB[0], voffB[1]); PG8_STAGE(PG8_SA(0, 1), Abase, aoC[1][0], aoC[1][1]);
    if (wr == 1) PG8_BAR;
    PG8_WAIT_V(4); PG8_BAR;
    PG8_STAGE(PG8_SB(1, 0), cB + kstep, voffB[0], voffB[1]); PG8_STAGE(PG8_SA(1, 0), Abase + kstep, aoC[0][0], aoC[0][1]);
    PG8_STAGE(PG8_SB(1, 1), cB + hstepB + kstep, voffB[0], voffB[1]);
    PG8_WAIT_V(6); PG8_BAR;
    for (;;) {
        const bool has_next = S.next(ui + 1, nxt);
        nxt.auxoff = ((ui + 1) % 3) * 2048;
        if constexpr (Sched::AUX) { if (has_next) __builtin_amdgcn_global_load_lds(S.aux_src(nxt, wid, lane), (LAS unsigned*)(lds + AUX_OFF + nxt.auxoff + wid * 256), 4, 0, 0); }
        if (has_next && !Sched::AUX) { PG8_AOFFS(aoN, nxt); }
        else {
#pragma unroll
            for (int h = 0; h < 2; ++h)
#pragma unroll
                for (int i = 0; i < 2; ++i) aoN[h][i] = aoC[h][i];
        }
        const char* nB = has_next ? nxt.Bp : cB;
#pragma clang loop unroll(disable)
        for (int t = 0; t < nt; t += 2) {
            const bool last = (t == nt - 2);
            if constexpr (Sched::AUX) { if (last && has_next) {
                _Pragma("unroll") for (int h = 0; h < 2; ++h) _Pragma("unroll") for (int i = 0; i < 2; ++i) { const int r = h * HALF + Rr[i]; const int row = (r < nxt.alim) ? ((const LAS int*)(lds + AUX_OFF + nxt.auxoff))[r] : 0;
                    aoN[h][i] = (unsigned)(row * ldab + Cc[i] * 2 + nxt.koff); } } }
            const char* a1 = Abase + (size_t)(t + 1) * kstep;
            const char* a2 = last ? Abase : Abase + (size_t)(t + 2) * kstep; const char* b2 = last ? nB : cB + (size_t)(t + 2) * kstep;
            const char* a3 = a2 + kstep; const char* b3 = b2 + kstep;
            const unsigned s00 = last ? aoN[0][0] : aoC[0][0], s01 = last ? aoN[0][1] : aoC[0][1], s10 = last ? aoN[1][0] : aoC[1][0], s11 = last ? aoN[1][1] : aoC[1][1];
            if constexpr (!FP8) {
            PG8_LDB(B0, 0, 0); PG8_SCHED; PG8_LDA(At, 0, 0); PG8_STAGE(PG8_SA(1, 1), a1, aoC[1][0], aoC[1][1]);
            PG8_WAIT_L(8); PG8_BAR; PG8_WAIT_L(0); PG8_MMA(0, 0, At, B0); PG8_BAR; PG8_SCHED;
            PG8_LDB(B1, 0, 1); PG8_STAGE(PG8_SB(0, 0), b2, voffB[0], voffB[1]);
            PG8_BAR; PG8_WAIT_L(0); PG8_MMA(0, 1, At, B1); PG8_BAR;
            PG8_LDA(At, 0, 1); PG8_STAGE(PG8_SA(0, 0), a2, s00, s01);
            PG8_BAR; PG8_WAIT_L(0); PG8_MMA(1, 0, At, B0); PG8_BAR; PG8_SCHED;
            PG8_STAGE(PG8_SB(0, 1), b2 + hstepB, voffB[0], voffB[1]);
            PG8_WAIT_V(6); PG8_BAR; PG8_MMA(1, 1, At, B1); PG8_BAR;
            PG8_LDB(B0, 1, 0); PG8_SCHED; PG8_LDA(At, 1, 0); PG8_STAGE(PG8_SA(0, 1), a2, s10, s11);
            PG8_WAIT_L(8); PG8_BAR; PG8_WAIT_L(0); PG8_MMA(0, 0, At, B0); PG8_BAR; PG8_SCHED;
            PG8_LDB(B1, 1, 1); PG8_STAGE(PG8_SB(1, 0), b3, voffB[0], voffB[1]);
            PG8_BAR; PG8_WAIT_L(0); PG8_MMA(0, 1, At, B1); PG8_BAR;
            PG8_LDA(At, 1, 1); PG8_STAGE(PG8_SA(1, 0), a3, s00, s01);
            PG8_BAR; PG8_WAIT_L(0); PG8_MMA(1, 0, At, B0); PG8_BAR; PG8_SCHED;
            PG8_STAGE(PG8_SB(1, 1), b3 + hstepB, voffB[0], voffB[1]);
            PG8_WAIT_V(6); PG8_BAR; PG8_MMA(1, 1, At, B1); PG8_BAR;
            } else {
            PG8_LDB(B0, 0, 0); PG8_SCHED; PG8_LDA(At, 0, 0); PG8_STAGE(PG8_SA(1, 1), a1, aoC[1][0], aoC[1][1]);
            PG8_WAIT_L(8); PG8_BAR; PG8_WAIT_L(0); PG8_MMA(0, 0, At, B0); PG8_BAR; PG8_SCHED;
            PG8_LDB(B0, 0, 1);
            PG8_BAR; PG8_WAIT_L(0); PG8_MMA(0, 1, At, B0); PG8_BAR; PG8_SCHED;
            PG8_LDB(B0, 0, 0); PG8_SCHED; PG8_LDA(At, 0, 1); PG8_STAGE(PG8_SA(0, 0), a2, s00, s01);
            PG8_WAIT_L(8); PG8_BAR; PG8_WAIT_L(0); PG8_MMA(1, 0, At, B0); PG8_BAR; PG8_SCHED;
            PG8_LDB(B0, 0, 1); PG8_STAGE(PG8_SB(0, 0), b2, voffB[0], voffB[1]);
            PG8_WAIT_V(4); PG8_WAIT_L(0); PG8_BAR; PG8_MMA(1, 1, At, B0); PG8_BAR; PG8_SCHED;
            PG8_LDB(B0, 1, 0); PG8_SCHED; PG8_LDA(At, 1, 0); PG8_STAGE(PG8_SA(0, 1), a2, s10, s11); PG8_STAGE(PG8_SB(0, 1), b2 + hstepB, voffB[0], voffB[1]);
            PG8_WAIT_L(8); PG8_BAR; PG8_WAIT_L(0); PG8_MMA(0, 0, At, B0); PG8_BAR; PG8_SCHED;
            PG8_LDB(B0, 1, 1);
            PG8_BAR; PG8_WAIT_L(0); PG8_MMA(0, 1, At, B0); PG8_BAR; PG8_SCHED;
            PG8_LDB(B0, 1, 0); PG8_SCHED; PG8_LDA(At, 1, 1); PG8_STAGE(PG8_SA(1, 0), a3, s00, s01);
            PG8_WAIT_L(8); PG8_BAR; PG8_WAIT_L(0); PG8_MMA(1, 0, At, B0); PG8_BAR; PG8_SCHED;
            PG8_LDB(B0, 1, 1); PG8_STAGE(PG8_SB(1, 0), b3, voffB[0], voffB[1]);
            PG8_WAIT_V(4); PG8_WAIT_L(0); PG8_BAR; PG8_MMA(1, 1, At, B0); PG8_BAR; PG8_SCHED;
            PG8_STAGE(PG8_SB(1, 1), b3 + hstepB, voffB[0], voffB[1]);
            }
        }
        if (wr == 0) PG8_BAR;
        E(acc, cur, wr, wc, fr, fq);
        if (!has_next) break;
        if (wr == 1) PG8_BAR;
#pragma unroll
        for (int a = 0; a < 2; ++a)
#pragma unroll
            for (int b = 0; b < 2; ++b)
#pragma unroll
                for (int m = 0; m < 4; ++m)
#pragma unroll
                    for (int n = 0; n < 2; ++n) acc[a][b][m][n] = (f32x4){0.f, 0.f, 0.f, 0.f};
        cur = nxt; cB = nB; ++ui;
#pragma unroll
        for (int h = 0; h < 2; ++h)
#pragma unroll
            for (int i = 0; i < 2; ++i) aoC[h][i] = aoN[h][i];
    }
    PG8_WAIT_V(0);
    PG8_BAR;
#undef PG8_SA
#undef PG8_SB
#undef PG8_STAGE
#undef PG8_LDA
#undef PG8_LDF
#undef PG8_LDB
#undef PG8_MMA
#undef PG8_WAIT_V
#undef PG8_WAIT_L
#undef PG8_BAR
#undef PG8_SCHED
#undef PG8_AOFFS
}
}
using pg8::Unit;

struct DenseSched {
    static constexpr bool AUX = false;
    const char* Bt; size_t tile_bytes; int nM, nN, G, c, lat, extra;
    __device__ __forceinline__ bool next(int i, Unit& u) const {
        const int L = i * G + c; int pm, pn;
        if (pg8::static_tile(L, nM, nN, pm, pn)) { if (lat) pm = (pm >> 3) * 9 + 1 + (pm & 7); }
        else { const int j = L - nM * nN; if (j < 0 || j >= extra) return false; pm = (j >> 2) * 9; pn = 8 + (j & 3); }
        u.Bp = Bt + (size_t)pn * tile_bytes; u.arow0 = pm * 256; u.alim = 256; u.orow0 = pm * 256; u.pn = pn; u.e = -1; u.koff = 0; return true;
    }
    __device__ __forceinline__ int arow(const Unit& u, int r) const { return u.arow0 + r; }
};
struct PanelSched {
    static constexpr bool AUX = false;
    const char* Bt; size_t tile_bytes; int nM, nN, G, c, lat, pm0;
    __device__ __forceinline__ bool next(int i, Unit& u) const {
        const int L = i * G + c; if (L >= nM * nN) return false;
        int pm = L / nN; const int pn = L - pm * nN; pm += pm0; if (lat) pm = (pm >> 3) * 9 + 1 + (pm & 7);
        u.Bp = Bt + (size_t)pn * tile_bytes; u.arow0 = pm * 256; u.alim = 256; u.orow0 = pm * 256; u.pn = pn; u.e = -1; u.koff = 0; return true;
    }
    __device__ __forceinline__ int arow(const Unit& u, int r) const { return u.arow0 + r; }
};
struct RouterSched {
    static constexpr bool AUX = false;
    const char* Bt; int nM, G, c, lat;
    __device__ __forceinline__ bool next(int i, Unit& u) const {
        const int L = i * G + c; if (L >= nM * 4) return false;
        int pm = L >> 2; const int ks = L & 3; if (lat) pm = (pm >> 3) * 9 + 1 + (pm & 7);
        u.koff = ks * 1024; u.Bp = Bt + u.koff; u.arow0 = pm * 256; u.alim = 256; u.orow0 = pm * 256; u.pn = ks; u.e = -1; return true;
    }
    __device__ __forceinline__ int arow(const Unit& u, int r) const { return u.arow0 + r; }
};
template <bool GATHER> struct MoeSched {
    static constexpr bool AUX = GATHER;
    const float* wlist_;
    __device__ __forceinline__ const unsigned* aux_src(const Unit& u, int wid, int lane) const { const int r = (wid & 3) * 64 + lane; return (wid < 4) ? (const unsigned*)(list + u.arow0 + r) : (const unsigned*)(wlist_ + u.arow0 + r); }
    const LAS int* ublk; const int* cnt; const int* list; const char* Bt; size_t e_stride; const char* Bts; size_t tile_bytes; int npn, nshared, lat, G, c;
    __device__ __forceinline__ bool next(int i, Unit& u) const {
        const int L = i * G + c; const int tot = ublk[NEXP]; if (L >= (tot + nshared) * npn) return false;
        const int mbg = L / npn, pn = L - mbg * npn;
        if (mbg < tot) { const int e = ((const LAS unsigned short*)(ublk + 128))[mbg]  , mb = mbg - ublk[e]; u.e = e; u.Bp = Bt + (size_t)e * e_stride + (size_t)pn * tile_bytes;
            u.arow0 = GATHER ? e * CAP + mb * 256 : mbg * 256; const int rem = cnt[e * CNT_STRIDE] - mb * 256; u.alim = rem < 256 ? rem : 256; }
        else { const int j = mbg - tot; u.e = -1; u.Bp = Bts + (size_t)pn * tile_bytes; const int pm = lat ? (j >> 3) * 9 + 1 + (j & 7) : j; u.arow0 = GATHER ? IDENT_OFF + pm * 256 : mbg * 256; u.alim = 256; }
        u.orow0 = mbg * 256; u.pn = pn; u.koff = 0; return true;
    }
    __device__ __forceinline__ int arow(const Unit& u, int r) const {
        if (GATHER) return (r < u.alim) ? list[u.arow0 + r] : 0;
        return u.arow0 + r;
    }
};

typedef f32x4 acc_t[2][2][4][2];
__device__ __forceinline__ unsigned pack4_fp8(float a, float b, float c, float d) {
    a = __builtin_amdgcn_fmed3f(a, -440.f, 440.f); b = __builtin_amdgcn_fmed3f(b, -440.f, 440.f); c = __builtin_amdgcn_fmed3f(c, -440.f, 440.f); d = __builtin_amdgcn_fmed3f(d, -440.f, 440.f);
    int w = __builtin_amdgcn_cvt_pk_fp8_f32(a, b, 0, false); w = __builtin_amdgcn_cvt_pk_fp8_f32(c, d, w, true); return (unsigned)w;
}

__device__ __forceinline__ u32x4 pack8(f32x4 v0, f32x4 v1) { u32x4 w; w.x = cvt_pk_bf16(v0[0], v0[1]); w.y = cvt_pk_bf16(v0[2], v0[3]); w.z = cvt_pk_bf16(v1[0], v1[1]); w.w = cvt_pk_bf16(v1[2], v1[3]); return w; }

struct EpiDown {
    static constexpr bool PERM = true;
    unsigned char* O; float* ssqp;
    __device__ __forceinline__ void operator()(const acc_t& acc, const Unit& u, int wr, int wc, int fr, int fq) const {
        const int row0 = u.orow0 + wr * 64 + fr, col0 = u.pn * 256 + wc * 64 + 16 * fq;
#pragma unroll
        for (int ai = 0; ai < 2; ++ai)
#pragma unroll
            for (int m = 0; m < 4; ++m) { const int row = row0 + ai * 128 + m * 16; float s = 0.f; u32x4 q;
#pragma unroll
                for (int bj = 0; bj < 2; ++bj) { const f32x4 v0 = acc[ai][bj][m][0] * (1.f / W1_SCALE), v1 = acc[ai][bj][m][1] * (1.f / W1_SCALE);
                    s += (v0[0] * v0[0] + v0[1] * v0[1]) + (v0[2] * v0[2] + v0[3] * v0[3]) + (v1[0] * v1[0] + v1[1] * v1[1]) + (v1[2] * v1[2] + v1[3] * v1[3]);
                    const unsigned p0 = pack4_fp8(v0[0], v0[1], v0[2], v0[3]), p1 = pack4_fp8(v1[0], v1[1], v1[2], v1[3]);
                    if (bj == 0) { q.x = p0; q.y = p1; } else { q.z = p0; q.w = p1; } }
                *(u32x4*)(O + (size_t)row * 1536 + col0) = q;
                s += __shfl_xor(s, 16); s += __shfl_xor(s, 32);
                if (fq == 0) ssqp[(size_t)row * 24 + u.pn * 4 + wc] = s; }
    }
};
struct EpiScaleBf16 {
    static constexpr bool PERM = true;
    bf16* O; int ldo; const float* ssqp; int p0, np; float invn; float ds;
    __device__ __forceinline__ void operator()(const acc_t& acc, const Unit& u, int wr, int wc, int fr, int fq) const {
        const int row0 = u.orow0 + wr * 64 + fr, col0 = u.pn * 256 + wc * 64 + 16 * fq;
        float rs8[8];
#pragma unroll
        for (int q = 0; q < 8; ++q) { rs8[q] = invn;
            if (ssqp) { const float* sp = ssqp + (size_t)(row0 + (q >> 2) * 128 + (q & 3) * 16) * 24 + p0; float t = 0.f;
                for (int i = 0; i < np; ++i) { const f32x4 qq = *(const f32x4*)(sp + 4 * i); t += (qq[0] + qq[1]) + (qq[2] + qq[3]); }
                rs8[q] = __builtin_amdgcn_rsqf(t * invn + EPS) * ds; } }
#pragma unroll
        for (int ai = 0; ai < 2; ++ai)
#pragma unroll
            for (int m = 0; m < 4; ++m) { const int row = row0 + ai * 128 + m * 16; const float rs = rs8[ai * 4 + m];
#pragma unroll
                for (int bj = 0; bj < 2; ++bj) *(u32x4*)(O + (size_t)row * ldo + col0 + bj * 8) = pack8(acc[ai][bj][m][0] * rs, acc[ai][bj][m][1] * rs); }
    }
};
struct EpiKV {
    static constexpr bool PERM = true;
    bf16* KV; unsigned char* KF; const unsigned char* down; const float* ssqp; const float* gk; LAS unsigned char* lds;
    __device__ __forceinline__ float rskv_of(int row) const { const float* sp = ssqp + (size_t)row * 24 + 12; const f32x4 q0 = *(const f32x4*)sp, q1 = *(const f32x4*)(sp + 4);
        return __builtin_amdgcn_rsqf((((q0[0] + q0[1]) + (q0[2] + q0[3])) + ((q1[0] + q1[1]) + (q1[2] + q1[3]))) * (1.f / 512.f) + EPS) * (1.f / W2_SCALE); }
    __device__ __forceinline__ void operator()(const acc_t& acc, const Unit& u, int wr, int wc, int fr, int fq) const {
        const int h = u.pn, r0 = wr * 64 + fr, pp = (u.orow0 >> 8) % 9;
        LAS float* xch = (LAS float*)(lds + LDS_MISC + 2048);
        if (wc < 2) {
#pragma unroll
            for (int ai = 0; ai < 2; ++ai)
#pragma unroll
                for (int m = 0; m < 4; ++m) { const float rskv = rskv_of(u.orow0 + r0 + ai * 128 + m * 16); float ss = 0.f;
#pragma unroll
                    for (int bj = 0; bj < 2; ++bj)
#pragma unroll
                        for (int n = 0; n < 2; ++n) { const f32x4 v = acc[ai][bj][m][n] * rskv; ss += (v[0] * v[0] + v[1] * v[1]) + (v[2] * v[2] + v[3] * v[3]); }
                    ss += __shfl_xor(ss, 16); ss += __shfl_xor(ss, 32);
                    if (fq == 0) xch[(wr * 2 + wc) * 128 + ai * 64 + m * 16 + fr] = ss; }
        }
        asm volatile("s_waitcnt lgkmcnt(0)" ::: "memory"); __builtin_amdgcn_s_barrier(); asm volatile("" ::: "memory");
        if (wc >= 2) {
            const int col0 = h * 256 + 128 + (wc - 2) * 64 + 16 * fq;
#pragma unroll
            for (int ai = 0; ai < 2; ++ai)
#pragma unroll
                for (int m = 0; m < 4; ++m) { const int row = u.orow0 + r0 + ai * 128 + m * 16; const float rs = rskv_of(row);
#pragma unroll
                    for (int bj = 0; bj < 2; ++bj) *(u32x4*)(KV + (size_t)row * 4096 + col0 + bj * 8) = pack8(acc[ai][bj][m][0] * rs, acc[ai][bj][m][1] * rs);
                    asm volatile("" ::: "memory"); }
        } else {
            const int c0 = wc * 64 + 16 * fq;
            const int rc = 32 * wc + 4 * fq;
#pragma unroll
            for (int ai = 0; ai < 2; ++ai)
#pragma unroll
                for (int m = 0; m < 4; ++m) { const int lr = ai * 64 + m * 16 + fr, row = u.orow0 + wr * 64 + ai * 128 + m * 16 + fr; const float rs = rskv_of(row);
                    const float ss = xch[(wr * 2) * 128 + lr] + xch[(wr * 2 + 1) * 128 + lr] + ssqp[(size_t)row * 24 + 20];
                    const float rsk = __builtin_amdgcn_rsqf(ss * (1.f / 192.f) + EPS), sc = rs * rsk;
                    u32x4 q8;
                    { const f32x4 v0 = acc[ai][0][m][0] * sc * *(const f32x4*)(gk + c0), v1 = acc[ai][0][m][1] * sc * *(const f32x4*)(gk + c0 + 4); q8.x = pack4_fp8(v0[0], v0[1], v0[2], v0[3]); q8.y = pack4_fp8(v1[0], v1[1], v1[2], v1[3]); }
                    { const f32x4 v0 = acc[ai][1][m][0] * sc * *(const f32x4*)(gk + c0 + 8), v1 = acc[ai][1][m][1] * sc * *(const f32x4*)(gk + c0 + 12); q8.z = pack4_fp8(v0[0], v0[1], v0[2], v0[3]); q8.w = pack4_fp8(v1[0], v1[1], v1[2], v1[3]); }
                    unsigned char* kp = KF + (size_t)row * 3072 + h * 192; *(u32x4*)(kp + c0) = q8;
                    const unsigned char* dp = down + (size_t)row * 1536 + 1280 + rc; const unsigned wa = *(const unsigned*)dp, wb = *(const unsigned*)(dp + 16);
                    const f32x4 ga = *(const f32x4*)(gk + 128 + rc), gb = *(const f32x4*)(gk + 128 + rc + 16);
                    const f32x2 a0 = __builtin_amdgcn_cvt_pk_f32_fp8((int)wa, false), a1 = __builtin_amdgcn_cvt_pk_f32_fp8((int)wa, true), b0 = __builtin_amdgcn_cvt_pk_f32_fp8((int)wb, false), b1 = __builtin_amdgcn_cvt_pk_f32_fp8((int)wb, true);
                    float ya[4] = {a0[0] * rsk * ga[0], a0[1] * rsk * ga[1], a1[0] * rsk * ga[2], a1[1] * rsk * ga[3]}, yb[4] = {b0[0] * rsk * gb[0], b0[1] * rsk * gb[1], b1[0] * rsk * gb[2], b1[1] * rsk * gb[3]};
                    if (pp != 0) { const int t = (pp - 1) * 256 + wr * 64 + ai * 128 + m * 16 + fr; const float pos = wc ? (float)(t & 63) : (float)(t >> 6);
#pragma unroll
                        for (int j = 0; j < 4; ++j) { const float fr_ = __builtin_amdgcn_exp2f(-(float)(4 * fq + j) * (1.f / 16.f) * 13.287712379549449f), ang = pos * fr_, cs = __cosf(ang), sn = __sinf(ang);
                            const float a = ya[j], b = yb[j]; ya[j] = a * cs - b * sn; yb[j] = b * cs + a * sn; } }
                    *(unsigned*)(kp + 128 + rc) = pack4_fp8(ya[0], ya[1], ya[2], ya[3]); *(unsigned*)(kp + 128 + rc + 16) = pack4_fp8(yb[0], yb[1], yb[2], yb[3]);
                    asm volatile("" ::: "memory"); }
        }
    }
};
struct EpiQKV1 {
    static constexpr bool PERM = true;
    bf16* RAW; unsigned char* KF; const float* gk; LAS unsigned char* lds;
    __device__ __forceinline__ void operator()(const acc_t& acc, const Unit& u, int wr, int wc, int fr, int fq) const {
        const int r0 = wr * 64 + fr; constexpr float DS = 1.f / W1_SCALE;
        if (u.pn != 8 && u.pn != 9) {
            const int col0 = u.pn * 256 + wc * 64 + 16 * fq;
#pragma unroll
            for (int ai = 0; ai < 2; ++ai)
#pragma unroll
                for (int m = 0; m < 4; ++m) { const int row = u.orow0 + r0 + ai * 128 + m * 16;
#pragma unroll
                    for (int bj = 0; bj < 2; ++bj) *(u32x4*)(RAW + (size_t)row * 3072 + col0 + bj * 8) = pack8(acc[ai][bj][m][0] * DS, acc[ai][bj][m][1] * DS); }
            return; }
        const int pp = (u.orow0 >> 8) % 9, hsel = wc >> 1, wl = wc & 1;
        LAS float* xch = (LAS float*)(lds + LDS_MISC + 2048);
#pragma unroll
        for (int ai = 0; ai < 2; ++ai)
#pragma unroll
            for (int m = 0; m < 4; ++m) { float ss = 0.f;
#pragma unroll
                for (int bj = 0; bj < 2; ++bj)
#pragma unroll
                    for (int n = 0; n < 2; ++n) { const f32x4 v = acc[ai][bj][m][n] * DS; ss += (v[0] * v[0] + v[1] * v[1]) + (v[2] * v[2] + v[3] * v[3]); }
                ss += __shfl_xor(ss, 16); ss += __shfl_xor(ss, 32);
                if (fq == 0) xch[(wr * 4 + wc) * 128 + ai * 64 + m * 16 + fr] = ss; }
        asm volatile("s_waitcnt lgkmcnt(0)" ::: "memory"); __builtin_amdgcn_s_barrier(); asm volatile("" ::: "memory");
        const int g = 2 * (u.pn - 8) + hsel, d0 = 64 * wl + 16 * fq;
        const bool second = (fq >> 1) != 0;
#pragma unroll
        for (int ai = 0; ai < 2; ++ai)
#pragma unroll
            for (int m = 0; m < 4; ++m) { const int lr = ai * 64 + m * 16 + fr, row = u.orow0 + wr * 64 + ai * 128 + m * 16 + fr;
                const float ss = xch[(wr * 4 + (wc & 2)) * 128 + lr] + xch[(wr * 4 + (wc | 1)) * 128 + lr];
                const float sc = __builtin_amdgcn_rsqf(ss * (1.f / 128.f) + EPS) * DS;
                float y[16];
#pragma unroll
                for (int bj = 0; bj < 2; ++bj)
#pragma unroll
                    for (int n = 0; n < 2; ++n) { const f32x4 gg = *(const f32x4*)(gk + d0 + 8 * bj + 4 * n); const f32x4 v = acc[ai][bj][m][n] * sc * gg;
                        y[8 * bj + 4 * n] = v[0]; y[8 * bj + 4 * n + 1] = v[1]; y[8 * bj + 4 * n + 2] = v[2]; y[8 * bj + 4 * n + 3] = v[3]; }
                if (pp != 0) { const int t = (pp - 1) * 256 + wr * 64 + ai * 128 + m * 16 + fr; const float pos = wl ? (float)(t & 63) : (float)(t >> 6);
#pragma unroll
                    for (int i = 0; i < 16; ++i) { const float oth = __shfl_xor(y[i], 32);
                        const float fr_ = __builtin_amdgcn_exp2f(-(float)(16 * (fq & 1) + i) * (1.f / 32.f) * 13.287712379549449f), ang = pos * fr_, cs = __cosf(ang), sn = __sinf(ang);
                        y[i] = second ? (y[i] * cs + oth * sn) : (y[i] * cs - oth * sn); } }
                u32x4 q8; q8.x = pack4_fp8(y[0], y[1], y[2], y[3]); q8.y = pack4_fp8(y[4], y[5], y[6], y[7]); q8.z = pack4_fp8(y[8], y[9], y[10], y[11]); q8.w = pack4_fp8(y[12], y[13], y[14], y[15]);
                *(u32x4*)(KF + (size_t)row * 512 + g * 128 + d0) = q8;
                asm volatile("" ::: "memory"); }
    }
};
struct EpiResid {
    static constexpr bool PERM = false;
    const float* x; const float* ctx; const bf16* hin; bf16* hout; const float* mod; int gate_off; int layer0; float ds;
    __device__ __forceinline__ void operator()(const acc_t& acc, const Unit& u, int wr, int wc, int fr, int fq) const {
        const int pm = u.orow0 >> 8, b = pm / 9, pp = pm - b * 9;
        const float* gate = mod + (size_t)(pp == 0 ? 8 : b) * NMOD + gate_off;
        const float* src = (pp == 0) ? ctx + (size_t)b * CTXL * DM : x + ((size_t)b * SEQ + (size_t)(pp - 1) * 256) * DM;
        const int r0 = wr * 64 + fr, col0 = u.pn * 256 + wc * 32 + 4 * fq;
        f32x4 gv[2][2];
#pragma unroll
        for (int bj = 0; bj < 2; ++bj)
#pragma unroll
            for (int n = 0; n < 2; ++n) gv[bj][n] = *(const f32x4*)(gate + col0 + bj * 128 + n * 16) * ds;
        if (layer0) batch<2, true>(acc, u, r0, col0, src, gv); else batch<4, false>(acc, u, r0, col0, src, gv);
    }
    template <int NB, bool L0> __device__ __forceinline__ void batch(const acc_t& acc, const Unit& u, int r0, int col0, const float* src, const f32x4 (&gv)[2][2]) const {
#pragma unroll
        for (int q0 = 0; q0 < 8; q0 += NB) { f32x4 hf[L0 ? NB : 1][4]; u32x2 hb[L0 ? 1 : NB][4];
#pragma unroll
            for (int s_ = 0; s_ < NB; ++s_) { const int q = q0 + s_, r = r0 + (q >> 2) * 128 + (q & 3) * 16;
#pragma unroll
                for (int e = 0; e < 4; ++e) { const int co = (e >> 1) * 128 + (e & 1) * 16;
                    if constexpr (L0) hf[s_][e] = *(const f32x4*)(src + (size_t)r * DM + col0 + co); else hb[s_][e] = *(const u32x2*)(hin + (size_t)(u.orow0 + r) * DM + col0 + co); } }
#pragma unroll
            for (int s_ = 0; s_ < NB; ++s_) { const int q = q0 + s_, ai = q >> 2, m = q & 3, r = r0 + ai * 128 + m * 16; const size_t ro = (size_t)(u.orow0 + r) * DM + col0;
#pragma unroll
                for (int e = 0; e < 4; ++e) { const int bj = e >> 1, n = e & 1, co = bj * 128 + n * 16; f32x4 hv;
                    if constexpr (L0) hv = hf[s_][e]; else hv = (f32x4){bf_lo(hb[s_][e].x), bf_hi(hb[s_][e].x), bf_lo(hb[s_][e].y), bf_hi(hb[s_][e].y)};
                    const f32x4 o = hv + gv[bj][n] * acc[ai][bj][m][n];
                    u32x2 qq; qq.x = cvt_pk_bf16(o[0], o[1]); qq.y = cvt_pk_bf16(o[2], o[3]); *(u32x2*)(hout + ro + co) = qq; } }
            asm volatile("" ::: "memory"); }
    }
};
struct EpiRouter {
    static constexpr bool PERM = false;
    float* lp;
    __device__ __forceinline__ void operator()(const acc_t& acc, const Unit& u, int wr, int wc, int fr, int fq) const {
        if (wc >= 2) return;
        const int row0 = u.orow0 + wr * 64 + fr, col0 = wc * 32 + 4 * fq; float* base = lp + (size_t)u.pn * MT * 64;
#pragma unroll
        for (int ai = 0; ai < 2; ++ai)
#pragma unroll
            for (int m = 0; m < 4; ++m) { float* rp = base + (size_t)(row0 + ai * 128 + m * 16) * 64 + col0;
#pragma unroll
                for (int n = 0; n < 2; ++n) *(f32x4*)(rp + n * 16) = acc[ai][0][m][n] + acc[ai][1][m][n]; }
    }
};
__device__ __forceinline__ float silu_mul(float g, float uu) { return g * __builtin_amdgcn_rcpf(1.f + __builtin_amdgcn_exp2f(-1.4426950408889634f * g)) * uu; }
struct EpiAct {
    static constexpr bool PERM = true;
    unsigned char* act; LAS unsigned char* lds; unsigned char* acts;
    __device__ __forceinline__ void operator()(const acc_t& acc, const Unit& u, int wr, int wc, int fr, int fq) const {
        const int r0 = wr * 64 + fr, col0 = u.pn * 128 + wc * 32 + 8 * fq; const bool sh = u.e < 0;
        unsigned char* const ob = sh ? acts + (size_t)(u.arow0 - IDENT_OFF) * DEXP : act + (size_t)u.orow0 * DEXP;
        const LAS float* wp = (const LAS float*)(lds + LDS_MISC + 2048 + u.auxoff) + 256;
        constexpr float IG = 1.f / W1_SCALE, IU = ACT_SCALE_R / W1_SCALE;
#pragma unroll
        for (int ai = 0; ai < 2; ++ai)
#pragma unroll
            for (int m = 0; m < 4; ++m) { const int r = r0 + ai * 128 + m * 16; const float wu = wp[r] * IU; float v[8];
#pragma unroll
                for (int j = 0; j < 4; ++j) { v[j] = silu_mul(acc[ai][0][m][0][j] * IG, acc[ai][1][m][0][j] * wu); v[4 + j] = silu_mul(acc[ai][0][m][1][j] * IG, acc[ai][1][m][1][j] * wu); }
                u32x2 w; w.x = pack4_fp8(v[0], v[1], v[2], v[3]); w.y = pack4_fp8(v[4], v[5], v[6], v[7]);
                *(u32x2*)(ob + (size_t)r * DEXP + col0) = w; }
    }
};
struct EpiY {
    static constexpr bool PERM = true;
    unsigned char* Y; float DS;
    __device__ __forceinline__ void operator()(const acc_t& acc, const Unit& u, int wr, int wc, int fr, int fq) const {
        const int r0 = wr * 64 + fr, col0 = u.pn * 256 + wc * 64 + 16 * fq;
#pragma unroll
        for (int ai = 0; ai < 2; ++ai)
#pragma unroll
            for (int m = 0; m < 4; ++m) { const int r = r0 + ai * 128 + m * 16; u32x4 q;
                { const f32x4 v0 = acc[ai][0][m][0] * DS, v1 = acc[ai][0][m][1] * DS; q.x = pack4_fp8(v0[0], v0[1], v0[2], v0[3]); q.y = pack4_fp8(v1[0], v1[1], v1[2], v1[3]); }
                { const f32x4 v0 = acc[ai][1][m][0] * DS, v1 = acc[ai][1][m][1] * DS; q.z = pack4_fp8(v0[0], v0[1], v0[2], v0[3]); q.w = pack4_fp8(v1[0], v1[1], v1[2], v1[3]); }
                *(u32x4*)(Y + (size_t)(u.orow0 + r) * DM + col0) = q; }
    }
};
struct EpiActS {
    static constexpr bool PERM = true;
    unsigned char* act;
    __device__ __forceinline__ void operator()(const acc_t& acc, const Unit& u, int wr, int wc, int fr, int fq) const {
        const int row0 = u.orow0 + wr * 64 + fr, col0 = u.pn * 128 + wc * 32 + 8 * fq;
        constexpr float IG = 1.f / W1_SCALE, IU = ACT_SCALE / W1_SCALE;
#pragma unroll
        for (int ai = 0; ai < 2; ++ai)
#pragma unroll
            for (int m = 0; m < 4; ++m) { float v[8];
#pragma unroll
                for (int j = 0; j < 4; ++j) { v[j] = silu_mul(acc[ai][0][m][0][j] * IG, acc[ai][1][m][0][j] * IU); v[4 + j] = silu_mul(acc[ai][0][m][1][j] * IG, acc[ai][1][m][1][j] * IU); }
                u32x2 w; w.x = pack4_fp8(v[0], v[1], v[2], v[3]); w.y = pack4_fp8(v[4], v[5], v[6], v[7]);
                *(u32x2*)(act + (size_t)(row0 + ai * 128 + m * 16) * DEXP + col0) = w; }
    }
};

namespace att {
constexpr int NW = 8, QBLK = 32;
#define SBAR() __builtin_amdgcn_sched_barrier(0)
__device__ __forceinline__ int crow(int r, int hi) { return (r & 3) + 8 * (r >> 2) + 4 * hi; }
template <int DQK> __device__ __forceinline__ int kswz(int row, int colB) {
    if constexpr (DQK == 128) return row * 256 + (colB ^ ((row & 15) << 4));
    else return row * 384 + (colB ^ (((row >> 1) & 7) << 4));
}
constexpr int OPITCH = 272;
template <int DQK, int KVB> constexpr size_t shm_attn() { return 2 * (size_t)KVB * 128 * 2 + 2 * (size_t)KVB * DQK * 2 + NW * 64 * 4 + NW * 32 * OPITCH; }

template <int NP> __device__ __forceinline__ void partialSM(f32x16& p0, f32x16& p1, float& m_reg, float& mn, float& alpha, const float C, const float thr) {
  float pmax = p0[0]; for (int r = 1; r < 16; ++r) pmax = fmaxf(pmax, p0[r]);
  if constexpr (NP == 2) { for (int r = 0; r < 16; ++r) pmax = fmaxf(pmax, p1[r]); }
  { auto rr = __builtin_amdgcn_permlane32_swap(__float_as_uint(pmax), __float_as_uint(pmax), false, false);
    pmax = fmaxf(__uint_as_float(rr[0]), __uint_as_float(rr[1])); }
  if (__builtin_expect(__all(pmax - m_reg <= thr), 1)) { mn = m_reg; alpha = 1.f; }
  else { mn = fmaxf(m_reg, pmax); alpha = __builtin_amdgcn_exp2f((m_reg - mn) * C); m_reg = mn; }
  float mnC = -mn * C;
  for (int r = 0; r < 16; ++r) p0[r] = fmaf(p0[r], C, mnC);
  if constexpr (NP == 2) { for (int r = 0; r < 16; ++r) p1[r] = fmaf(p1[r], C, mnC); for (int r = 0; r < 16; ++r) p0[r] = __builtin_amdgcn_exp2f(p0[r]); }
  else { for (int r = 0; r < 8; ++r) p0[r] = __builtin_amdgcn_exp2f(p0[r]); }
}
template <int NP> __device__ __forceinline__ void finishSM(f32x16& p0, f32x16& p1, float alpha, float& l_reg, bf16x8& pa0, bf16x8& pa1, bf16x8& pa2, bf16x8& pa3) {
  if constexpr (NP == 2) { for (int r = 0; r < 16; ++r) p1[r] = __builtin_amdgcn_exp2f(p1[r]); } else { for (int r = 8; r < 16; ++r) p0[r] = __builtin_amdgcn_exp2f(p0[r]); }
  float ps = 0; for (int r = 0; r < 16; ++r) ps += p0[r];
  if constexpr (NP == 2) { for (int r = 0; r < 16; ++r) ps += p1[r]; }
  { auto rr = __builtin_amdgcn_permlane32_swap(__float_as_uint(ps), __float_as_uint(ps), false, false);
    ps = __uint_as_float(rr[0]) + __uint_as_float(rr[1]); }
  l_reg = l_reg * alpha + ps;
#define PK4(P, BASE, OUT) do { unsigned a0 = cvt_pk_bf16(P[BASE + 0], P[BASE + 1]), a1 = cvt_pk_bf16(P[BASE + 2], P[BASE + 3]);   \
    unsigned b0 = cvt_pk_bf16(P[BASE + 4], P[BASE + 5]), b1 = cvt_pk_bf16(P[BASE + 6], P[BASE + 7]);                              \
    auto r0 = __builtin_amdgcn_permlane32_swap(a0, b0, false, false); auto r1 = __builtin_amdgcn_permlane32_swap(a1, b1, false, false); \
    u32x4 w = {r0[0], r1[0], r0[1], r1[1]}; OUT = *reinterpret_cast<bf16x8*>(&w); } while (0)
  PK4(p0, 0, pa0); PK4(p0, 8, pa1);
  if constexpr (NP == 2) { PK4(p1, 0, pa2); PK4(p1, 8, pa3); }
#undef PK4
}
template <int DQK, int NP> __device__ __forceinline__ void qkt(f32x16& p0, f32x16& p1, const char* Ks, const bf16x8* qr, int r32, int hi) {
  p0 = f32x16{}; if constexpr (NP == 2) p1 = f32x16{};
  for (int d0 = 0; d0 < DQK / 16; ++d0) { int cb = (d0 * 16 + hi * 8) * 2;
    bf16x8 b0 = *reinterpret_cast<const bf16x8*>(Ks + kswz<DQK>(r32, cb));
    p0 = __builtin_amdgcn_mfma_f32_32x32x16_bf16(b0, qr[d0], p0, 0, 0, 0);
    if constexpr (NP == 2) { bf16x8 b1 = *reinterpret_cast<const bf16x8*>(Ks + kswz<DQK>(32 + r32, cb)); p1 = __builtin_amdgcn_mfma_f32_32x32x16_bf16(b1, qr[d0], p1, 0, 0, 0); } }
}
__device__ __forceinline__ int v_st(int k, int c) { const int kk = (k & ~0xC) | ((k & 4) << 1) | ((k & 8) >> 1); return ((kk >> 3) * 4 + (c >> 5)) * 512 + ((kk & 7) * 32 + (c & 31)) * 2; }
__device__ __forceinline__ int v_rd_base(int lane) { return ((lane & 3) << 3) | (((lane >> 2) & 3) << 6) | (((lane >> 4) & 1) << 5) | (((lane >> 5) & 1) << 8); }
constexpr int v_rd_off(int d0, int ks, int half) { return d0 * 512 + ks * 4096 + half * 2048; }
template <int OFF> __device__ __forceinline__ s16x4 tr_read(int vb) {
  s16x4 r; asm volatile("ds_read_b64_tr_b16 %0, %1 offset:%2" : "=&v"(r) : "v"(vb), "i"(OFF) : "memory"); return r;
}
#define PK(L, H) (bf16x8){L[0], L[1], L[2], L[3], H[0], H[1], H[2], H[3]}
template <int D0, int NP> __device__ __forceinline__ void pv_one(f32x16& od, int vb, bf16x8 pa0, bf16x8 pa1, bf16x8 pa2, bf16x8 pa3) {
  if constexpr (NP == 2) {
    const s16x4 l0 = tr_read<v_rd_off(D0, 0, 0)>(vb), h0 = tr_read<v_rd_off(D0, 0, 1)>(vb), l1 = tr_read<v_rd_off(D0, 1, 0)>(vb), h1 = tr_read<v_rd_off(D0, 1, 1)>(vb);
    const s16x4 l2 = tr_read<v_rd_off(D0, 2, 0)>(vb), h2 = tr_read<v_rd_off(D0, 2, 1)>(vb), l3 = tr_read<v_rd_off(D0, 3, 0)>(vb), h3 = tr_read<v_rd_off(D0, 3, 1)>(vb);
    asm volatile("s_waitcnt lgkmcnt(0)" ::: "memory"); SBAR();
    od = __builtin_amdgcn_mfma_f32_32x32x16_bf16(pa0, PK(l0, h0), od, 0, 0, 0);
    od = __builtin_amdgcn_mfma_f32_32x32x16_bf16(pa1, PK(l1, h1), od, 0, 0, 0);
    od = __builtin_amdgcn_mfma_f32_32x32x16_bf16(pa2, PK(l2, h2), od, 0, 0, 0);
    od = __builtin_amdgcn_mfma_f32_32x32x16_bf16(pa3, PK(l3, h3), od, 0, 0, 0);
  } else {
    const s16x4 l0 = tr_read<v_rd_off(D0, 0, 0)>(vb), h0 = tr_read<v_rd_off(D0, 0, 1)>(vb), l1 = tr_read<v_rd_off(D0, 1, 0)>(vb), h1 = tr_read<v_rd_off(D0, 1, 1)>(vb);
    asm volatile("s_waitcnt lgkmcnt(0)" ::: "memory"); SBAR();
    od = __builtin_amdgcn_mfma_f32_32x32x16_bf16(pa0, PK(l0, h0), od, 0, 0, 0);
    od = __builtin_amdgcn_mfma_f32_32x32x16_bf16(pa1, PK(l1, h1), od, 0, 0, 0);
  }
}
#undef PK
template <int NP> __device__ __forceinline__ void pv_d0(f32x16* o, int vb, bf16x8 pa0, bf16x8 pa1, bf16x8 pa2, bf16x8 pa3) {
  pv_one<0, NP>(o[0], vb, pa0, pa1, pa2, pa3); pv_one<1, NP>(o[1], vb, pa0, pa1, pa2, pa3); pv_one<2, NP>(o[2], vb, pa0, pa1, pa2, pa3); pv_one<3, NP>(o[3], vb, pa0, pa1, pa2, pa3);
}

template <int DQK, int KVB, int LDQ, int LDK, int LDV, int LDO>
__device__ __forceinline__ void attn_body(const bf16* __restrict__ Qb, const bf16* __restrict__ Kh, const bf16* __restrict__ Vh, unsigned char* __restrict__ Ob, const int seq, const float scale, const float* __restrict__ qgain, const int tpos0, char* lds) {
  static_assert((DQK == 128 && KVB == 64) || (DQK == 192 && KVB == 32), "supported bodies");
  constexpr int ND0 = DQK / 16, NP = KVB / 32;
  constexpr size_t SHM_V = (size_t)KVB * 128 * 2, SHM_K = (size_t)KVB * DQK * 2;
  int lane_ = threadIdx.x & 63; asm volatile("" : "+v"(lane_));
  const int wid = __builtin_amdgcn_readfirstlane(threadIdx.x >> 6), lane = lane_, tid = wid * 64 + lane, r32 = lane & 31, hi = lane >> 5;
  const float C = scale * 1.4426950408889634f, thr = 8.f / scale;
  char* V_lds = lds; char* K_lds = lds + 2 * SHM_V;
  float* ws = (float*)(lds + 2 * SHM_V + 2 * SHM_K) + wid * 64; float* li_l = ws; float* al_l = ws + 32;
  char* O_lds = lds + 2 * SHM_V + 2 * SHM_K + NW * 64 * 4 + wid * (32 * OPITCH);
  float m_reg = -1e30f, l_reg = 0; f32x16 o[4] = {}; bf16x8 qr[ND0];
  const bf16* Qw = Qb + (wid * QBLK + r32) * LDQ + hi * 8;
  { u32x4 raw[ND0]; float ss = 0.f;
#pragma unroll
    for (int d0 = 0; d0 < ND0; ++d0) raw[d0] = *reinterpret_cast<const u32x4*>(Qw + d0 * 16);
#pragma unroll
    for (int d0 = 0; d0 < ND0; ++d0) { float x[8]; x[0] = bf_lo(raw[d0].x); x[1] = bf_hi(raw[d0].x); x[2] = bf_lo(raw[d0].y); x[3] = bf_hi(raw[d0].y); x[4] = bf_lo(raw[d0].z); x[5] = bf_hi(raw[d0].z); x[6] = bf_lo(raw[d0].w); x[7] = bf_hi(raw[d0].w);
#pragma unroll
      for (int j = 0; j < 8; ++j) ss += x[j] * x[j]; }
    { auto rr = __builtin_amdgcn_permlane32_swap(__float_as_uint(ss), __float_as_uint(ss), false, false); ss = __uint_as_float(rr[0]) + __uint_as_float(rr[1]); }
    const float rs = __builtin_amdgcn_rsqf(ss * (1.f / DQK) + EPS);
    const int tq = tpos0 + wid * QBLK + r32; const float prow = (float)(tq >> 6), pcol = (float)(tq & 63);
    constexpr int RD0 = (DQK == 192) ? 8 : 0;
    constexpr int GQ = (DQK == 192) ? 1 : 2;
    constexpr float NQI = (DQK == 192) ? (1.f / 16.f) : (1.f / 32.f);
    float y[ND0][8];
#pragma unroll
    for (int d0 = 0; d0 < ND0; ++d0) { const f32x4 g0 = *(const f32x4*)(qgain + d0 * 16 + hi * 8), g1 = *(const f32x4*)(qgain + d0 * 16 + hi * 8 + 4);
      y[d0][0] = bf_lo(raw[d0].x) * rs * g0[0]; y[d0][1] = bf_hi(raw[d0].x) * rs * g0[1]; y[d0][2] = bf_lo(raw[d0].y) * rs * g0[2]; y[d0][3] = bf_hi(raw[d0].y) * rs * g0[3];
      y[d0][4] = bf_lo(raw[d0].z) * rs * g1[0]; y[d0][5] = bf_hi(raw[d0].z) * rs * g1[1]; y[d0][6] = bf_lo(raw[d0].w) * rs * g1[2]; y[d0][7] = bf_hi(raw[d0].w) * rs * g1[3]; }
    if (tpos0 >= 0) {
#pragma unroll
      for (int pr = 0; pr < 2; ++pr)
#pragma unroll
        for (int f = 0; f < GQ; ++f) { const int da = RD0 + (2 * pr) * GQ + f, db = da + GQ; const float pos = pr ? pcol : prow;
#pragma unroll
          for (int j = 0; j < 8; ++j) { const int jf = f * 16 + hi * 8 + j;
            const float fr_ = __builtin_amdgcn_exp2f(-(float)jf * NQI * 13.287712379549449f), ang = pos * fr_, cs = __cosf(ang), sn = __sinf(ang);
            const float a = y[da][j], b = y[db][j]; y[da][j] = a * cs - b * sn; y[db][j] = b * cs + a * sn; } }
    }
#pragma unroll
    for (int d0 = 0; d0 < ND0; ++d0) { u32x4 w; w.x = cvt_pk_bf16(y[d0][0], y[d0][1]); w.y = cvt_pk_bf16(y[d0][2], y[d0][3]); w.z = cvt_pk_bf16(y[d0][4], y[d0][5]); w.w = cvt_pk_bf16(y[d0][6], y[d0][7]);
      qr[d0] = *reinterpret_cast<bf16x8*>(&w); }
  }
  const int sr = tid >> 4, sc = (tid & 15) * 8;
  const int kr0 = (DQK == 128) ? sr : tid / 24, kc0 = (DQK == 128) ? sc : (tid % 24) * 8;
  const int kr1 = (DQK == 128) ? 32 + sr : (512 + tid) / 24, kc1 = (DQK == 128) ? sc : ((512 + tid) % 24) * 8;
  const bool k1v = (DQK == 128) || tid < 256;
  const int vb0 = (int)(uintptr_t)V_lds + v_rd_base(lane);
  struct { bf16x8 vs0, vs1, ks0, ks1; } sr_[2];
#define SLOAD(i, k0) do { sr_[i].vs0 = *reinterpret_cast<const bf16x8*>(&Vh[(long)((k0) + sr) * LDV + sc]); \
    if constexpr (NP == 2) sr_[i].vs1 = *reinterpret_cast<const bf16x8*>(&Vh[(long)((k0) + 32 + sr) * LDV + sc]); \
    sr_[i].ks0 = *reinterpret_cast<const bf16x8*>(&Kh[(long)((k0) + kr0) * LDK + kc0]); \
    if (k1v) sr_[i].ks1 = *reinterpret_cast<const bf16x8*>(&Kh[(long)((k0) + kr1) * LDK + kc1]); } while (0)
#define SWRITE(b, i) do { *(bf16x8*)(V_lds + (b) * SHM_V + v_st(sr, sc)) = sr_[i].vs0; \
    if constexpr (NP == 2) *(bf16x8*)(V_lds + (b) * SHM_V + v_st(32 + sr, sc)) = sr_[i].vs1; \
    *(bf16x8*)(K_lds + (b) * SHM_K + kswz<DQK>(kr0, kc0 * 2)) = sr_[i].ks0; \
    if (k1v) *(bf16x8*)(K_lds + (b) * SHM_K + kswz<DQK>(kr1, kc1 * 2)) = sr_[i].ks1; } while (0)
#define SWAIT() do { if constexpr (NP == 2) asm volatile("s_waitcnt vmcnt(4)" ::: "memory"); else { if (wid < 4) asm volatile("s_waitcnt vmcnt(3)" ::: "memory"); else asm volatile("s_waitcnt vmcnt(2)" ::: "memory"); } } while (0)
#define RESC(a) do { if (__any((a) < 1.f)) { if (hi == 0) al_l[r32] = (a); asm volatile("s_waitcnt lgkmcnt(0)" ::: "memory"); \
    for (int d = 0; d < 4; ++d) for (int r = 0; r < 16; ++r) o[d][r] *= al_l[crow(r, hi)]; } } while (0)
  f32x16 pA0, pA1, pB0, pB1; float mnA, mnB, alA, alB; bf16x8 pa0, pa1, pa2, pa3; const int NT = seq / KVB;
  constexpr int SE = 0, SO = 1;
  SLOAD(SE, 0); asm volatile("s_waitcnt vmcnt(0)" ::: "memory"); SWRITE(0, SE); __syncthreads();
  qkt<DQK, NP>(pA0, pA1, K_lds, qr, r32, hi); partialSM<NP>(pA0, pA1, m_reg, mnA, alA, C, thr);
  SLOAD(SO, KVB); if (2 < NT) SLOAD(SE, 2 * KVB);
  SWAIT(); SWRITE(1, SO); __syncthreads();
  for (int j = 1; j + 1 < NT; j += 2) {
    SBAR(); qkt<DQK, NP>(pB0, pB1, K_lds + SHM_K, qr, r32, hi);
    finishSM<NP>(pA0, pA1, alA, l_reg, pa0, pa1, pa2, pa3); SBAR();
    SLOAD(SO, (j + 2) * KVB); SBAR();
    pv_d0<NP>(o, vb0, pa0, pa1, pa2, pa3); partialSM<NP>(pB0, pB1, m_reg, mnB, alB, C, thr);
    __syncthreads(); SWAIT(); SWRITE(0, SE);
    RESC(alB); __syncthreads();
    SBAR(); qkt<DQK, NP>(pA0, pA1, K_lds, qr, r32, hi);
    finishSM<NP>(pB0, pB1, alB, l_reg, pa0, pa1, pa2, pa3); SBAR();
    if (j + 3 < NT) SLOAD(SE, (j + 3) * KVB); SBAR();
    pv_d0<NP>(o, vb0 + (int)SHM_V, pa0, pa1, pa2, pa3); partialSM<NP>(pA0, pA1, m_reg, mnA, alA, C, thr);
    __syncthreads(); SWAIT(); SWRITE(1, SO);
    RESC(alA); __syncthreads();
  }
  SBAR(); qkt<DQK, NP>(pB0, pB1, K_lds + SHM_K, qr, r32, hi);
  finishSM<NP>(pA0, pA1, alA, l_reg, pa0, pa1, pa2, pa3); SBAR();
  pv_d0<NP>(o, vb0, pa0, pa1, pa2, pa3); partialSM<NP>(pB0, pB1, m_reg, mnB, alB, C, thr);
  __syncthreads(); RESC(alB);
  finishSM<NP>(pB0, pB1, alB, l_reg, pa0, pa1, pa2, pa3); SBAR();
  pv_d0<NP>(o, vb0 + (int)SHM_V, pa0, pa1, pa2, pa3);
  if (hi == 0) li_l[r32] = l_reg; asm volatile("s_waitcnt lgkmcnt(0)" ::: "memory");
#pragma unroll
  for (int r = 0; r < 16; ++r) { const float rl = O_SCALE * __builtin_amdgcn_rcpf(li_l[crow(r, hi)]); char* rowp = O_lds + crow(r, hi) * OPITCH + r32;
#pragma unroll
    for (int d0 = 0; d0 < 4; ++d0) *(unsigned char*)(rowp + d0 * 32) = (unsigned char)(pack4_fp8(o[d0][r] * rl, 0.f, 0.f, 0.f) & 0xffu); }
  asm volatile("s_waitcnt lgkmcnt(0)" ::: "memory");
  unsigned char* Ow = Ob + (wid * QBLK) * LDO;
#pragma unroll
  for (int i = 0; i < 4; ++i) { const int row = 8 * i + (lane >> 3), cch = (lane & 7) * 16;
    const u32x4 w = *(const u32x4*)(O_lds + row * OPITCH + cch); *(u32x4*)(Ow + row * LDO + cch) = w; }
  asm volatile("s_waitcnt lgkmcnt(0)" ::: "memory");
  __syncthreads();
#undef SLOAD
#undef SWRITE
#undef SWAIT
#undef RESC
}
template <int DQK> __device__ __forceinline__ int ksw8(int row, int c16) {
    if constexpr (DQK == 128) return row * 128 + ((c16 ^ ((row >> 1) & 7)) << 4);
    else return row * 256 + ((c16 ^ (row & 15)) << 4);
}
template <int DQK> __device__ __forceinline__ void qkt8(f32x16& p0, f32x16& p1, const char* Ks, const v8i32* q8, int r32, int hi) {
  p0 = f32x16{}; p1 = f32x16{};
#pragma unroll
  for (int s_ = 0; s_ < DQK / 64; ++s_) { const int a0 = ksw8<DQK>(r32, 4 * s_ + 2 * hi), a1 = ksw8<DQK>(32 + r32, 4 * s_ + 2 * hi);
    const v8i32 b0 = __builtin_shufflevector(*reinterpret_cast<const v4i32*>(Ks + a0), *reinterpret_cast<const v4i32*>(Ks + (a0 ^ 16)), 0, 1, 2, 3, 4, 5, 6, 7);
    const v8i32 b1 = __builtin_shufflevector(*reinterpret_cast<const v4i32*>(Ks + a1), *reinterpret_cast<const v4i32*>(Ks + (a1 ^ 16)), 0, 1, 2, 3, 4, 5, 6, 7);
    p0 = __builtin_amdgcn_mfma_scale_f32_32x32x64_f8f6f4(b0, q8[s_], p0, 0, 0, 0, 0, 0, 0);
    p1 = __builtin_amdgcn_mfma_scale_f32_32x32x64_f8f6f4(b1, q8[s_], p1, 0, 0, 0, 0, 0, 0); }
}
template <int DQK, int LDQ, int LDK, int LDV, int LDO>
__device__ __forceinline__ void attn_body8(const int wid, const bf16* __restrict__ Qb, const unsigned char* __restrict__ Kh, const bf16* __restrict__ Vh, unsigned char* __restrict__ Ob, const int seq, const float scale, const float* __restrict__ qgain, const int tpos0, char* lds) {
  static_assert(DQK == 128 || DQK == 192, "supported head dims");
  constexpr int KVB = 64, NP = 2, NS = DQK / 64, KPITCH = (DQK == 128) ? 128 : 256, KPC = DQK / 16;
  constexpr size_t SHM_V = (size_t)KVB * 128 * 2, SHM_K = (size_t)KVB * KPITCH;
  int lane_ = lane_id(); asm volatile("" : "+v"(lane_));
  const int lane = lane_, tid = wid * 64 + lane, r32 = lane & 31, hi = lane >> 5;
  const float C = scale * 1.4426950408889634f, thr = 8.f / scale;
  char* V_lds = lds; char* K_lds = lds + 2 * SHM_V;
  float* ws = (float*)(lds + 2 * SHM_V + 2 * SHM_K) + wid * 64; float* li_l = ws; float* al_l = ws + 32;
  char* O_lds = lds + 2 * SHM_V + 2 * SHM_K + NW * 64 * 4 + wid * (32 * OPITCH);
  float m_reg = -1e30f, l_reg = 0; f32x16 o[4] = {}; v8i32 q8[NS];
  {
    const bf16* Qw = Qb + (wid * QBLK + r32) * LDQ + hi * 32;
    u32x4 raw[NS][4]; float ss = 0.f;
#pragma unroll
    for (int s_ = 0; s_ < NS; ++s_)
#pragma unroll
      for (int q_ = 0; q_ < 4; ++q_) raw[s_][q_] = *reinterpret_cast<const u32x4*>(Qw + s_ * 64 + q_ * 8);
    float y[NS][32];
#pragma unroll
    for (int s_ = 0; s_ < NS; ++s_)
#pragma unroll
      for (int q_ = 0; q_ < 4; ++q_) { float* x = &y[s_][q_ * 8]; x[0] = bf_lo(raw[s_][q_].x); x[1] = bf_hi(raw[s_][q_].x); x[2] = bf_lo(raw[s_][q_].y); x[3] = bf_hi(raw[s_][q_].y);
        x[4] = bf_lo(raw[s_][q_].z); x[5] = bf_hi(raw[s_][q_].z); x[6] = bf_lo(raw[s_][q_].w); x[7] = bf_hi(raw[s_][q_].w);
#pragma unroll
        for (int j = 0; j < 8; ++j) ss += x[j] * x[j]; }
    { auto rr = __builtin_amdgcn_permlane32_swap(__float_as_uint(ss), __float_as_uint(ss), false, false); ss = __uint_as_float(rr[0]) + __uint_as_float(rr[1]); }
    const float rs = __builtin_amdgcn_rsqf(ss * (1.f / DQK) + EPS);
#pragma unroll
    for (int s_ = 0; s_ < NS; ++s_)
#pragma unroll
      for (int q_ = 0; q_ < 8; ++q_) { const f32x4 g = *(const f32x4*)(qgain + s_ * 64 + hi * 32 + q_ * 4);
#pragma unroll
        for (int j = 0; j < 4; ++j) y[s_][q_ * 4 + j] *= rs * g[j]; }
    if (tpos0 >= 0) { const int tq = tpos0 + wid * QBLK + r32; const float prow = (float)(tq >> 6), pcol = (float)(tq & 63);
      if constexpr (DQK == 192) {
        const float pos = hi ? pcol : prow;
#pragma unroll
        for (int j = 0; j < 16; ++j) { const float fr_ = __builtin_amdgcn_exp2f(-(float)j * (1.f / 16.f) * 13.287712379549449f), ang = pos * fr_, cs = __cosf(ang), sn = __sinf(ang);
          const float a = y[2][j], b = y[2][16 + j]; y[2][j] = a * cs - b * sn; y[2][16 + j] = b * cs + a * sn; }
      } else {
#pragma unroll
        for (int s_ = 0; s_ < 2; ++s_) { const float pos = s_ ? pcol : prow;
#pragma unroll
          for (int j = 0; j < 32; ++j) { const float own = y[s_][j];
            auto rr = __builtin_amdgcn_permlane32_swap(__float_as_uint(own), __float_as_uint(own), false, false);
            const float oth = __uint_as_float(hi ? rr[0] : rr[1]);
            const float fr_ = __builtin_amdgcn_exp2f(-(float)j * (1.f / 32.f) * 13.287712379549449f), ang = pos * fr_, cs = __cosf(ang), sn = __sinf(ang);
            y[s_][j] = hi ? (own * cs + oth * sn) : (own * cs - oth * sn); } }
      }
    }
#pragma unroll
    for (int s_ = 0; s_ < NS; ++s_) { v8i32 w;
#pragma unroll
      for (int q_ = 0; q_ < 8; ++q_) w[q_] = (int)pack4_fp8(y[s_][4 * q_], y[s_][4 * q_ + 1], y[s_][4 * q_ + 2], y[s_][4 * q_ + 3]);
      q8[s_] = w; }
  }
  constexpr int KCH = (int)(SHM_K / 1024) / NW, VCH = (int)(SHM_V / 1024) / NW;
  const unsigned lds_u = (unsigned)(uintptr_t)lds;
  unsigned kgo[KCH], vgo[VCH];
#pragma unroll
  for (int q = 0; q < KCH; ++q) { const int o = (q * NW + wid) * 1024 + lane * 16, row = o / KPITCH, slot = (o % KPITCH) >> 4;
    const int c16 = (DQK == 128) ? (slot ^ ((row >> 1) & 7)) : (slot ^ (row & 15)); kgo[q] = (unsigned)(row * LDK + (c16 < KPC ? c16 : 0) * 16); }
#pragma unroll
  for (int q = 0; q < VCH; ++q) { const int o = (q * NW + wid) * 1024 + lane * 16, st = o >> 9, within = (o & 511) >> 1, kk = (st >> 2) * 8 + (within >> 5), c = (st & 3) * 32 + (within & 31);
    const int k = (kk & ~0xC) | ((kk & 4) << 1) | ((kk & 8) >> 1); vgo[q] = (unsigned)((k * LDV + c) * 2); }
  const int vb0 = (int)(uintptr_t)V_lds + v_rd_base(lane);
  const int NT = seq / KVB;
#define KDMA(b, t_) do { const char* kp_ = (const char*)Kh + (size_t)((t_) < NT ? (t_) : NT - 1) * KVB * LDK; _Pragma("unroll") for (int q = 0; q < KCH; ++q) \
    __builtin_amdgcn_global_load_lds((const unsigned*)(kp_ + kgo[q]), (LAS unsigned*)(size_t)(lds_u + (unsigned)(2 * SHM_V + (b) * SHM_K + (q * NW + wid) * 1024)), 16, 0, 0); } while (0)
#define VDMA(b, t_) do { const char* vp_ = (const char*)Vh + (size_t)((t_) < NT ? (t_) : NT - 1) * KVB * LDV * 2; _Pragma("unroll") for (int q = 0; q < VCH; ++q) \
    __builtin_amdgcn_global_load_lds((const unsigned*)(vp_ + vgo[q]), (LAS unsigned*)(size_t)(lds_u + (unsigned)((b) * SHM_V + (q * NW + wid) * 1024)), 16, 0, 0); } while (0)
#define DMA_WAIT() asm volatile("s_waitcnt vmcnt(0)" ::: "memory")
#define RESC(a) do { if (__any((a) < 1.f)) { if (hi == 0) al_l[r32] = (a); asm volatile("s_waitcnt lgkmcnt(0)" ::: "memory"); \
    for (int d = 0; d < 4; ++d) for (int r = 0; r < 16; ++r) o[d][r] *= al_l[crow(r, hi)]; } } while (0)
  f32x16 pA0, pA1, pB0, pB1; float mnA, mnB, alA, alB; bf16x8 pa0, pa1, pa2, pa3;
  KDMA(0, 0); VDMA(0, 0); KDMA(1, 1); DMA_WAIT(); __syncthreads();
  qkt8<DQK>(pA0, pA1, K_lds, q8, r32, hi); partialSM<NP>(pA0, pA1, m_reg, mnA, alA, C, thr);
  asm volatile("s_waitcnt lgkmcnt(0)" ::: "memory"); __syncthreads();
  KDMA(0, 2); VDMA(1, 1);
#define STEP(X0, X1, alX, Y0, Y1, mnY, alY, j_) do { SBAR(); if ((j_) + 1 < NT) qkt8<DQK>(Y0, Y1, K_lds + (((j_) + 1) & 1) * SHM_K, q8, r32, hi); \
    finishSM<NP>(X0, X1, alX, l_reg, pa0, pa1, pa2, pa3); SBAR(); \
    pv_d0<NP>(o, vb0 + ((j_) & 1) * (int)SHM_V, pa0, pa1, pa2, pa3); if ((j_) + 1 < NT) { partialSM<NP>(Y0, Y1, m_reg, mnY, alY, C, thr); RESC(alY); } \
    DMA_WAIT(); asm volatile("s_waitcnt lgkmcnt(0)" ::: "memory"); __syncthreads(); \
    KDMA(((j_) + 1) & 1, (j_) + 3); VDMA((j_) & 1, (j_) + 2); } while (0)
  for (int j = 0; j < NT; j += 2) {
    STEP(pA0, pA1, alA, pB0, pB1, mnB, alB, j);
    STEP(pB0, pB1, alB, pA0, pA1, mnA, alA, j + 1);
  }
  DMA_WAIT(); __syncthreads();
#undef STEP
#undef KDMA
#undef VDMA
#undef DMA_WAIT
  if (hi == 0) li_l[r32] = l_reg; asm volatile("s_waitcnt lgkmcnt(0)" ::: "memory");
#pragma unroll
  for (int r = 0; r < 16; ++r) { const float rl = O_SCALE * __builtin_amdgcn_rcpf(li_l[crow(r, hi)]); char* rowp = O_lds + crow(r, hi) * OPITCH + r32;
#pragma unroll
    for (int d0 = 0; d0 < 4; ++d0) *(unsigned char*)(rowp + d0 * 32) = (unsigned char)(pack4_fp8(o[d0][r] * rl, 0.f, 0.f, 0.f) & 0xffu); }
  asm volatile("s_waitcnt lgkmcnt(0)" ::: "memory");
  unsigned char* Ow = Ob + (wid * QBLK) * LDO;
#pragma unroll
  for (int i = 0; i < 4; ++i) { const int row = 8 * i + (lane >> 3), cch = (lane & 7) * 16;
    const u32x4 w = *(const u32x4*)(O_lds + row * OPITCH + cch); *(u32x4*)(Ow + row * LDO + cch) = w; }
  asm volatile("s_waitcnt lgkmcnt(0)" ::: "memory");
  __syncthreads();
#undef RESC
}
}

struct Params { const float* in[28]; float* out; unsigned char* ws; int ph_lo, ph_hi; };
typedef const __attribute__((address_space(4))) Params* KP;
enum { I_X = 0, I_C, I_CTX, I_CCTX, I_ADAW, I_ADAB, I_N1G, I_N2G, I_MLA_WDOWN, I_MLA_GQ, I_MLA_GKV, I_MLA_WUQ, I_MLA_WUKV, I_MLA_GQN, I_MLA_GKN, I_MLA_WO,
       I_GQA_WQKV, I_GQA_GQN, I_GQA_GKN, I_GQA_WO, I_MOE_WR, I_MOE_BR, I_MOE_WG, I_MOE_WU, I_MOE_WD, I_MOE_SG, I_MOE_SU, I_MOE_SD };

__device__ __forceinline__ void cvt_tile(const float* __restrict__ W, const int N, const int k0, const int n0, bf16* __restrict__ dst, const int ldk, const float* __restrict__ gain, const int mode,
                                         LAS float* scr, const int lane, const int rmap = -1, const int nbase = 0) {
    f32x4 v[16];
#pragma unroll
    for (int i = 0; i < 16; ++i) { const int kk = 4 * i + (lane >> 4); v[i] = *(const f32x4*)(W + (size_t)(k0 + kk) * N + n0 + (lane & 15) * 4); }
    if (gain) {
#pragma unroll
        for (int i = 0; i < 16; ++i) v[i] *= gain[k0 + 4 * i + (lane >> 4)]; }
#pragma unroll
    for (int i = 0; i < 16; ++i) { const int kk = 4 * i + (lane >> 4); LAS float* s = scr + kk * 65 + (lane & 15) * 4; s[0] = v[i][0]; s[1] = v[i][1]; s[2] = v[i][2]; s[3] = v[i][3]; }
    LDS_WAIT(); asm volatile("" ::: "memory");
    const int c = lane >> 3, nn = lane & 7;
#pragma unroll
    for (int jj = 0; jj < 8; ++jj) { const int n = 8 * jj + nn; const LAS float* s = scr + (8 * c) * 65 + n;
        float x[8];
#pragma unroll
        for (int j = 0; j < 8; ++j) x[j] = s[j * 65];
        u32x4 w; w.x = cvt_pk_bf16(x[0], x[1]); w.y = cvt_pk_bf16(x[2], x[3]); w.z = cvt_pk_bf16(x[4], x[5]); w.w = cvt_pk_bf16(x[6], x[7]);
        const int ng = nbase + n, orow = rmap < 0 ? n : ((ng >> 3) * 16 + rmap + (ng & 7));
        *(u32x4*)(dst + (size_t)orow * ldk + k0 + 8 * c) = w;
        if (mode == 1) { float y[8];
#pragma unroll
            for (int j = 0; j < 8; ++j) { const unsigned wj = (j & 1) ? (w[j >> 1] & 0xffff0000u) : (w[j >> 1] << 16); y[j] = x[j] - __uint_as_float(wj); }
            u32x4 w2; w2.x = cvt_pk_bf16(y[0], y[1]); w2.y = cvt_pk_bf16(y[2], y[3]); w2.z = cvt_pk_bf16(y[4], y[5]); w2.w = cvt_pk_bf16(y[6], y[7]);
            *(u32x4*)(dst + (size_t)(n + 128) * ldk + k0 + 8 * c) = w2; } }
    LDS_WAIT(); asm volatile("" ::: "memory");
}
__device__ __forceinline__ void cvt_f8_load(f32x4 (&v)[16], const float* __restrict__ W, const int N, const int k0, const int n0, const int lane) {
#pragma unroll
    for (int i = 0; i < 16; ++i) { const int kk = 8 * i + (lane >> 3); v[i] = __builtin_nontemporal_load((const f32x4*)(W + (size_t)(k0 + kk) * N + n0 + (lane & 7) * 4)); }
}
__device__ __forceinline__ void cvt_f8_finish(const f32x4 (&v)[16], const int k0, unsigned char* __restrict__ dst, const int ldk, const float scale, LAS float* scr, const int lane, const int rmap = -1, const int nbase = 0) {
#pragma unroll
    for (int i = 0; i < 16; ++i) { const int kk = 8 * i + (lane >> 3); LAS float* s = scr + kk * 33 + (lane & 7) * 4; s[0] = v[i][0] * scale; s[1] = v[i][1] * scale; s[2] = v[i][2] * scale; s[3] = v[i][3] * scale; }
    LDS_WAIT(); asm volatile("" ::: "memory");
    const int c = lane & 7, nq = lane >> 3;
#pragma unroll
    for (int jj = 0; jj < 4; ++jj) { const int n = nq + 8 * jj; const LAS float* s = scr + (16 * c) * 33 + n;
        float x[16];
#pragma unroll
        for (int j = 0; j < 16; ++j) x[j] = s[j * 33];
        u32x4 w; w.x = pack4_fp8(x[0], x[1], x[2], x[3]); w.y = pack4_fp8(x[4], x[5], x[6], x[7]); w.z = pack4_fp8(x[8], x[9], x[10], x[11]); w.w = pack4_fp8(x[12], x[13], x[14], x[15]);
        const int ng = nbase + n, orow = rmap < 0 ? n : ((ng >> 3) * 16 + rmap + (ng & 7));
        *(u32x4*)(dst + (size_t)orow * ldk + k0 + 16 * c) = w; }
    LDS_WAIT(); asm volatile("" ::: "memory");
}
__device__ __forceinline__ void cvt_tile_f8(const float* __restrict__ W, const int N, const int k0, const int n0, unsigned char* __restrict__ dst, const int ldk, const float scale, LAS float* scr, const int lane, const float* __restrict__ gain = nullptr) {
    f32x4 v[16]; cvt_f8_load(v, W, N, k0, n0, lane);
    if (gain) {
#pragma unroll
        for (int i = 0; i < 16; ++i) v[i] *= gain[k0 + 8 * i + (lane >> 3)]; }
    cvt_f8_finish(v, k0, dst, ldk, scale, scr, lane);
}
struct MoeItem { const float* W; unsigned char* dst; int N, k0, n0, ldk, rmap, nbase; float scale; };
__device__ __forceinline__ MoeItem moe_item(KP P, int idx) {
    unsigned char* ws = P->ws; MoeItem m; const int kind = idx / (2 * 64 * 256), q = idx - kind * (2 * 64 * 256), le = q >> 8, t = q & 255;
    if (kind < 2) { const int kb = t >> 4, nb = t & 15, n0 = nb * 32; m.W = P->in[kind ? I_MOE_WU : I_MOE_WG] + (size_t)le * DM * DEXP; m.N = DEXP; m.k0 = kb * 128; m.n0 = n0;
        m.dst = (unsigned char*)(ws + WS_MOE1) + ((size_t)le * 1024 + (n0 >> 7) * 256) * 2048; m.ldk = 2048; m.scale = W1_SCALE; m.rmap = kind * 8; m.nbase = n0 & 127; }
    else { const int kb = t >> 6, nb = t & 63; m.W = P->in[I_MOE_WD] + (size_t)le * DEXP * DM; m.N = DM; m.k0 = kb * 128; m.n0 = nb * 32;
        m.dst = (unsigned char*)(ws + WS_MOE2) + ((size_t)le * 2048 + nb * 32) * 512; m.ldk = 512; m.scale = W2_SCALE; m.rmap = -1; m.nbase = 0; }
    return m;
}
struct MoeBlk { const float* W; unsigned char* dst; int N, k0, n0, ldk, rmap; float scale; };
__device__ __forceinline__ MoeBlk moe_blk(KP P, int idx) {
    unsigned char* ws = P->ws; MoeBlk m; const int kind = idx / (128 * 64), q = idx - kind * (128 * 64), le = q >> 6, t = q & 63;
    if (kind < 2) { const int kb = t >> 2, nb = t & 3; m.W = P->in[kind ? I_MOE_WU : I_MOE_WG] + (size_t)le * DM * DEXP; m.N = DEXP; m.k0 = kb * 128; m.n0 = nb * 128;
        m.dst = (unsigned char*)(ws + WS_MOE1) + ((size_t)le * 1024 + nb * 256) * 2048; m.ldk = 2048; m.scale = W1_SCALE; m.rmap = kind * 8; }
    else { const int kb = t >> 4, nb = t & 15; m.W = P->in[I_MOE_WD] + (size_t)le * DEXP * DM; m.N = DM; m.k0 = kb * 128; m.n0 = nb * 128;
        m.dst = (unsigned char*)(ws + WS_MOE2) + ((size_t)le * 2048 + nb * 128) * 512; m.ldk = 512; m.scale = W2_SCALE; m.rmap = -1; }
    return m;
}
__device__ __forceinline__ void blk_load(f32x4 (&v)[8], const MoeBlk& m, int tid) {
#pragma unroll
    for (int i = 0; i < 8; ++i) v[i] = __builtin_nontemporal_load((const f32x4*)(m.W + (size_t)(m.k0 + i * 16 + (tid >> 5)) * m.N + m.n0 + (tid & 31) * 4));
}
__device__ __forceinline__ void cvt_moe_blocks(KP P, LAS float* sb, int l, int vcu, int G, int tid_) {
    constexpr int NBLK = 3 * 64 * 64, D = 3;
    int tid = tid_; asm volatile("" : "+v"(tid));
    const int per = (NBLK + G - 1) / G; const int it0 = vcu * per; const int end = it0 + per < NBLK ? it0 + per : NBLK;
    if (it0 >= end) return;
#define MOE_BLK_L(j) moe_blk(P, ((j) >> 12) * (128 * 64) + l * 4096 + ((j) & 4095))
    f32x4 v[D][8];
#pragma unroll
    for (int d = 0; d < D; ++d) { const int j = it0 + d < end ? it0 + d : end - 1; const MoeBlk m = MOE_BLK_L(j); blk_load(v[d], m, tid); }
    int p = 0;
    for (int base = it0; base < end; base += D) {
#pragma unroll
        for (int d = 0; d < D; ++d) { const int cur = base + d < end ? base + d : end - 1;
            const MoeBlk mc = MOE_BLK_L(cur); LAS float* sp = sb + p * (128 * 128);
#pragma unroll
            for (int i = 0; i < 8; ++i) { const int k = i * 16 + (tid >> 5); *(LAS f32x4*)(sp + k * 128 + (((tid & 31) * 4) ^ (4 * ((k >> 4) & 7)))) = v[d][i] * mc.scale; }
            { const int jn = cur + D < end ? cur + D : end - 1; const MoeBlk mn = MOE_BLK_L(jn); blk_load(v[d], mn, tid); }
            LDS_WAIT(); __syncthreads();
            { const int n = tid >> 2, c = tid & 3; u32x4 w0, w1; float x[32];
#pragma unroll
              for (int j = 0; j < 32; ++j) { const int k = 32 * c + j; x[j] = sp[k * 128 + (n ^ (4 * ((k >> 4) & 7)))]; }
              w0.x = pack4_fp8(x[0], x[1], x[2], x[3]); w0.y = pack4_fp8(x[4], x[5], x[6], x[7]); w0.z = pack4_fp8(x[8], x[9], x[10], x[11]); w0.w = pack4_fp8(x[12], x[13], x[14], x[15]);
              w1.x = pack4_fp8(x[16], x[17], x[18], x[19]); w1.y = pack4_fp8(x[20], x[21], x[22], x[23]); w1.z = pack4_fp8(x[24], x[25], x[26], x[27]); w1.w = pack4_fp8(x[28], x[29], x[30], x[31]);
              const int orow = mc.rmap < 0 ? n : ((n >> 3) * 16 + mc.rmap + (n & 7));
              unsigned char* dd = mc.dst + (size_t)orow * mc.ldk + mc.k0 + 32 * c; __builtin_nontemporal_store(w0, (u32x4*)dd); __builtin_nontemporal_store(w1, (u32x4*)(dd + 16)); }
            p ^= 1;
        }
    }
    LDS_WAIT(); __syncthreads();
#undef MOE_BLK_L
}
__device__ __forceinline__ float silu_f(float x) { return x / (1.f + __expf(-x)); }
__device__ __forceinline__ void mod_block(KP P, float* mod, LAS float* red, int blk, int wave, int lane, int tid) {
    const int l = blk / 48, nb = blk % 48, k0 = wave * 256, n = nb * 256 + lane * 4;
    const float* W = P->in[I_ADAW] + (size_t)l * DM * NMOD; const float* cc = P->in[I_C]; const float* cx = P->in[I_CCTX];
    f32x4 a[9];
#pragma unroll
    for (int r = 0; r < 9; ++r) a[r] = (f32x4){0.f, 0.f, 0.f, 0.f};
    for (int kb = 0; kb < 256; kb += 64) {
        float s[9];
#pragma unroll
        for (int r = 0; r < 8; ++r) s[r] = silu_f(cc[r * DM + k0 + kb + lane]);
        s[8] = silu_f(cx[k0 + kb + lane]);
#pragma unroll 4
        for (int j = 0; j < 64; ++j) { const f32x4 w = *(const f32x4*)(W + (size_t)(k0 + kb + j) * NMOD + n);
#pragma unroll
            for (int r = 0; r < 9; ++r) { const float sj = __uint_as_float(__builtin_amdgcn_readlane((int)__float_as_uint(s[r]), j)); a[r] += w * sj; } }
    }
#pragma unroll
    for (int r = 0; r < 9; ++r) *(LAS f32x4*)(red + (wave * 9 + r) * 256 + lane * 4) = a[r];
    LDS_WAIT(); __syncthreads();
    for (int o = tid; o < 9 * 256; o += NTHREADS) { const int r = o >> 8, c = o & 255; float t = P->in[I_ADAB][(size_t)l * NMOD + nb * 256 + c];
#pragma unroll
        for (int w = 0; w < 8; ++w) t += red[(w * 9 + r) * 256 + c];
        mod[((size_t)l * 9 + r) * NMOD + nb * 256 + c] = t; }
    __syncthreads();
}
__device__ __forceinline__ void p0_prologue(KP P, LAS unsigned char* lds, int vcu, int G, int gw, int NGW, int wave, int lane) {
    unsigned char* ws = P->ws;
    LAS float* scr = (LAS float*)(lds + wave * 16896);
    float* mod = (float*)(ws + WS_CTL + CTL_MOD);
    for (int blk = vcu; blk < 96; blk += G) mod_block(P, mod, (LAS float*)lds, blk, wave, lane, wave * 64 + lane);
    constexpr int N_MOD = 0, N_ZERO = 192 + 2 * 128;
    constexpr int T_DOWN = 32 * 21, T_UQ = 12 * 48, T_UKV = 8 * 64, T_WO = 32 * 32, T_QKV = 32 * 48, T_SG = 2 * 32 * 8, T_SD = 2 * 8 * 32, T_R = 2 * 32;
    constexpr int NITEMS = N_MOD + N_ZERO + T_DOWN + T_UQ + T_UKV + T_WO + T_QKV + T_WO + T_SG + T_SG + T_SD + T_R;
    static_assert(NITEMS >= 5120 + 1536 && NITEMS <= 5120 + 1536 + 1280, "item deal");
    for (int k = 0; ; ++k) { int it;
        if (G == 256) { if (vcu >= 96) { const int A = (vcu - 96) * 8 + wave; it = k < 4 ? A + 1280 * k : (k == 4 && 5120 + 1536 + A < NITEMS) ? 5120 + 1536 + A : -1; }
                        else { const int b = vcu * 8 + wave; it = k < 2 ? 5120 + 768 * k + b : -1; } }
        else it = gw + k * NGW;
        if (it < 0 || it >= NITEMS) break;
        int r = it;
        if (r < N_ZERO) {
            bf16* row;
            if (r < 192) { if (r >= 96) continue; row = (bf16*)((unsigned char*)(ws + WS_BT_DOWN) + (size_t)1344 * 2048 + (size_t)r * 4096); }
            else { const int q = r - 192, l = q >> 7, j = q & 127; row = (bf16*)(ws + WS_BT_R) + ((size_t)l * 256 + (j < 64 ? 64 + j : 128 + j)) * 2048; }
            const u32x4 z = {0u, 0u, 0u, 0u};
#pragma unroll
            for (int j = 0; j < 4; ++j) *(u32x4*)(row + (j * 64 + lane) * 8) = z;
            continue; } r -= N_ZERO;
        if (r < T_DOWN) { const int kb = r / 42, nb = r % 42; cvt_tile_f8(P->in[I_MLA_WDOWN], 1344, kb * 128, nb * 32, (unsigned char*)(ws + WS_BT_DOWN) + (size_t)(nb * 32) * 2048, 2048, W1_SCALE, scr, lane); continue; } r -= T_DOWN;
        if (r < T_UQ) { const int kb = r / 96, nb = r % 96; cvt_tile_f8(P->in[I_MLA_WUQ], 3072, kb * 128, nb * 32, (unsigned char*)(ws + WS_BT_UQ) + (size_t)(nb * 32) * 768, 768, W2_SCALE, scr, lane, P->in[I_MLA_GQ]); continue; } r -= T_UQ;
        if (r < T_UKV) { const int kb = r / 128, nb = r % 128; cvt_tile_f8(P->in[I_MLA_WUKV], 4096, kb * 128, nb * 32, (unsigned char*)(ws + WS_BT_UKV) + (size_t)(nb * 32) * 512, 512, W2_SCALE, scr, lane, P->in[I_MLA_GKV]); continue; } r -= T_UKV;
        if (r < T_WO) { const int kb = r / 64, nb = r % 64; cvt_tile_f8(P->in[I_MLA_WO], 2048, kb * 128, nb * 32, (unsigned char*)(ws + WS_BT_WO0) + (size_t)(nb * 32) * 2048, 2048, W1_SCALE, scr, lane); continue; } r -= T_WO;
        if (r < T_QKV) { const int kb = r / 96, nb = r % 96; cvt_tile_f8(P->in[I_GQA_WQKV], 3072, kb * 128, nb * 32, (unsigned char*)(ws + WS_BT_QKV) + (size_t)(nb * 32) * 2048, 2048, W1_SCALE, scr, lane); continue; } r -= T_QKV;
        if (r < T_WO) { const int kb = r / 64, nb = r % 64; cvt_tile_f8(P->in[I_GQA_WO], 2048, kb * 128, nb * 32, (unsigned char*)(ws + WS_BT_WO1) + (size_t)(nb * 32) * 2048, 2048, W1_SCALE, scr, lane); continue; } r -= T_WO;
        if (r < 2 * T_SG) { const int up = r / T_SG, q = r % T_SG, l = q / 256, t = q % 256, kb = t / 16, nb = t % 16, n0 = nb * 32;
            f32x4 v[16]; const float* W = P->in[up ? I_MOE_SU : I_MOE_SG] + (size_t)l * DM * DEXP; cvt_f8_load(v, W, DEXP, kb * 128, n0, lane);
            cvt_f8_finish(v, kb * 128, (unsigned char*)(ws + WS_BT_S1) + ((size_t)l * 1024 + (n0 >> 7) * 256) * 2048, 2048, W1_SCALE, scr, lane, up * 8, n0 & 127); continue; } r -= 2 * T_SG;
        if (r < T_SD) { const int l = r / 256, t = r % 256, kb = t / 64, nb = t % 64; cvt_tile_f8(P->in[I_MOE_SD] + (size_t)l * DEXP * DM, DM, kb * 128, nb * 32, (unsigned char*)(ws + WS_BT_S2) + ((size_t)l * 2048 + nb * 32) * 512, 512, W2_SCALE, scr, lane); continue; } r -= T_SD;
        if (r < T_R) { const int l = r / 32, kb = r % 32; cvt_tile(P->in[I_MOE_WR] + (size_t)l * DM * NEXP, NEXP, kb * 64, 0, (bf16*)(ws + WS_BT_R) + (size_t)l * 256 * 2048, 2048, nullptr, 1, scr, lane); continue; } r -= T_R;
        (void)r;
    }
    __syncthreads();
}

__device__ __forceinline__ void row_load_bf(const bf16* p, int lane, f32x4 (&v)[8]) {
#pragma unroll
    for (int j = 0; j < 8; ++j) { const u32x2 w = *(const u32x2*)(p + j * 256 + lane * 4); v[j] = (f32x4){bf_lo(w.x), bf_hi(w.x), bf_lo(w.y), bf_hi(w.y)}; }
}
__device__ __forceinline__ void row_load(const float* p, int lane, f32x4 (&v)[8]) {
#pragma unroll
    for (int j = 0; j < 8; ++j) v[j] = __builtin_nontemporal_load((const f32x4*)(p + j * 256 + lane * 4));
}
__device__ __forceinline__ void norm_mod_store(const f32x4 (&v)[8], const float* g, const float* sh, const float* sc, bf16* out, int lane, unsigned char* out8 = nullptr) {
    float ss = 0.f;
#pragma unroll
    for (int j = 0; j < 8; ++j) ss += (v[j][0] * v[j][0] + v[j][1] * v[j][1]) + (v[j][2] * v[j][2] + v[j][3] * v[j][3]);
    const float rs = __builtin_amdgcn_rsqf(wave_sum(ss) * (1.f / DM) + EPS);
#pragma unroll
    for (int j = 0; j < 8; ++j) { const int c = j * 256 + lane * 4; const f32x4 gg = *(const f32x4*)(g + c), s1 = *(const f32x4*)(sc + c), s0 = *(const f32x4*)(sh + c);
        const f32x4 y = v[j] * rs * gg * (s1 + 1.f) + s0; if (out) { u32x2 w; w.x = cvt_pk_bf16(y[0], y[1]); w.y = cvt_pk_bf16(y[2], y[3]); *(u32x2*)(out + c) = w; }
        if (out8) *(unsigned*)(out8 + c) = pack4_fp8(y[0], y[1], y[2], y[3]); }
}
__device__ __forceinline__ void mod_load(const float* g, const float* sh, const float* sc, int lane, f32x4 (&gg)[8], f32x4 (&s0)[8]) {
#pragma unroll
    for (int j = 0; j < 8; ++j) { const int c = j * 256 + lane * 4; gg[j] = *(const f32x4*)(g + c) * (*(const f32x4*)(sc + c) + 1.f); s0[j] = *(const f32x4*)(sh + c); }
}
__device__ __forceinline__ void norm_apply(const f32x4 (&v)[8], const f32x4 (&gg)[8], const f32x4 (&s0)[8], int lane, bf16* out, unsigned char* out8) {
    float ss = 0.f;
#pragma unroll
    for (int j = 0; j < 8; ++j) ss += (v[j][0] * v[j][0] + v[j][1] * v[j][1]) + (v[j][2] * v[j][2] + v[j][3] * v[j][3]);
    const float rs = __builtin_amdgcn_rsqf(wave_sum(ss) * (1.f / DM) + EPS);
#pragma unroll
    for (int j = 0; j < 8; ++j) { const int c = j * 256 + lane * 4; const f32x4 y = v[j] * rs * gg[j] + s0[j];
        if (out) { u32x2 w; w.x = cvt_pk_bf16(y[0], y[1]); w.y = cvt_pk_bf16(y[2], y[3]); *(u32x2*)(out + c) = w; }
        if (out8) *(unsigned*)(out8 + c) = pack4_fp8(y[0], y[1], y[2], y[3]); }
}
__device__ __forceinline__ void row_info(int T, int& b, int& p, int& r) { b = T / TPB; p = T - b * TPB; r = p < CTXL ? 8 : b; }

__device__ __forceinline__ void rope8(float (&y)[8], const float (&yp)[8], float pos, int j0, float nq_inv, bool second) {
#pragma unroll
    for (int j = 0; j < 8; ++j) { const float f = __builtin_amdgcn_exp2f(-(float)(j0 + j) * nq_inv * 13.287712379549449f);
        const float ang = pos * f; const float cs = __cosf(ang), sn = __sinf(ang);
        y[j] = second ? (y[j] * cs + yp[j] * sn) : (y[j] * cs - yp[j] * sn); }
}
__device__ __forceinline__ void unpack8(const u32x4 w, float (&x)[8]) { x[0] = bf_lo(w.x); x[1] = bf_hi(w.x); x[2] = bf_lo(w.y); x[3] = bf_hi(w.y); x[4] = bf_lo(w.z); x[5] = bf_hi(w.z); x[6] = bf_lo(w.w); x[7] = bf_hi(w.w); }
__device__ __forceinline__ u32x4 pack8f(const float (&y)[8]) { u32x4 w; w.x = cvt_pk_bf16(y[0], y[1]); w.y = cvt_pk_bf16(y[2], y[3]); w.z = cvt_pk_bf16(y[4], y[5]); w.w = cvt_pk_bf16(y[6], y[7]); return w; }

__device__ __forceinline__ void mla_finalize_token(KP P, int T, int lane) {
    unsigned char* ar = P->ws + WS_ARENA;
    const bf16* qraw = (const bf16*)(ar + AR_QRAW) + (size_t)T * 3072; const bf16* kvraw = (const bf16*)(ar + AR_KVRAW) + (size_t)T * 4096; const unsigned char* down = (const unsigned char*)(ar + AR_DOWN) + (size_t)T * 1536;
    unsigned char* kf = (unsigned char*)(ar + AR_KF) + (size_t)T * 3072;
    int b, p, rr; row_info(T, b, p, rr); const bool rot = p >= CTXL; const int t = p - CTXL; const float prow = (float)(t >> 6), pcol = (float)(t & 63);
    const int c = lane & 31, half = lane >> 5; const bool act = c < 24; const int cc = act ? c : 0;
    const int rc = cc - 16, quarter = rc >> 1; const bool isrope = cc >= 16;
#pragma unroll
    for (int which = 1; which < 2; ++which) {
        const float* gain = P->in[which ? I_MLA_GKN : I_MLA_GQN] + cc * 8;
        const f32x4 g0 = *(const f32x4*)gain, g1 = *(const f32x4*)(gain + 4);
        for (int hs = 0; hs < 8; ++hs) { const int h = hs * 2 + half;
            float x[8];
            if (isrope) { const u32x2 w8 = *(const u32x2*)(down + 1280 + rc * 8);
                const f32x2 p0 = __builtin_amdgcn_cvt_pk_f32_fp8((int)w8.x, false), p1 = __builtin_amdgcn_cvt_pk_f32_fp8((int)w8.x, true), p2 = __builtin_amdgcn_cvt_pk_f32_fp8((int)w8.y, false), p3 = __builtin_amdgcn_cvt_pk_f32_fp8((int)w8.y, true);
                x[0] = p0[0]; x[1] = p0[1]; x[2] = p1[0]; x[3] = p1[1]; x[4] = p2[0]; x[5] = p2[1]; x[6] = p3[0]; x[7] = p3[1]; }
            else { const u32x4 w = *(const u32x4*)(kvraw + h * 256 + cc * 8); unpack8(w, x); }
            float ss = 0.f;
#pragma unroll
            for (int j = 0; j < 8; ++j) ss += x[j] * x[j];
            if (!act) ss = 0.f;
#pragma unroll
            for (int o = 1; o < 32; o <<= 1) ss += __shfl_xor(ss, o);
            const float rs = __builtin_amdgcn_rsqf(ss * (1.f / 192.f) + EPS);
            float y[8], yp[8];
#pragma unroll
            for (int j = 0; j < 4; ++j) { y[j] = x[j] * rs * g0[j]; y[4 + j] = x[4 + j] * rs * g1[j]; }
#pragma unroll
            for (int j = 0; j < 8; ++j) yp[j] = __shfl_xor(y[j], 2);
            if (rot && isrope) rope8(y, yp, quarter < 2 ? prow : pcol, (rc & 1) * 8, 1.f / 16.f, (quarter & 1) != 0);
            if (act) { u32x2 q8_; q8_.x = pack4_fp8(y[0], y[1], y[2], y[3]); q8_.y = pack4_fp8(y[4], y[5], y[6], y[7]); *(u32x2*)(kf + h * 192 + cc * 8) = q8_; }
        }
    }
}
__device__ __forceinline__ void gqa_finalize_token(KP P, int T, int lane) {
    unsigned char* ar = P->ws + WS_ARENA;
    const bf16* raw = (const bf16*)(ar + AR_QRAW) + (size_t)T * 3072;
    unsigned char* kf = (unsigned char*)(ar + AR_KF) + (size_t)T * 512;
    int b, p, rr; row_info(T, b, p, rr); const bool rot = p >= CTXL; const int t = p - CTXL; const float prow = (float)(t >> 6), pcol = (float)(t & 63);
    const int c = lane & 15, grp = lane >> 4, quarter = c >> 2;
    for (int step = 4; step < 5; ++step) {
        const bool isk = step == 4; const int h = isk ? grp : step * 4 + grp;
        const float* gain = P->in[isk ? I_GQA_GKN : I_GQA_GQN] + c * 8;
        const f32x4 g0 = *(const f32x4*)gain, g1 = *(const f32x4*)(gain + 4);
        const bf16* src = raw + (isk ? 2048 : 0) + h * 128 + c * 8;
        u32x4 w = *(const u32x4*)src; float x[8]; unpack8(w, x);
        float ss = 0.f;
#pragma unroll
        for (int j = 0; j < 8; ++j) ss += x[j] * x[j];
#pragma unroll
        for (int o = 1; o < 16; o <<= 1) ss += __shfl_xor(ss, o);
        const float rs = __builtin_amdgcn_rsqf(ss * (1.f / 128.f) + EPS);
        float y[8], yp[8];
#pragma unroll
        for (int j = 0; j < 4; ++j) { y[j] = x[j] * rs * g0[j]; y[4 + j] = x[4 + j] * rs * g1[j]; }
#pragma unroll
        for (int j = 0; j < 8; ++j) yp[j] = __shfl_xor(y[j], 4);
        if (rot) rope8(y, yp, quarter < 2 ? prow : pcol, (c & 3) * 8, 1.f / 32.f, (quarter & 1) != 0);
        { u32x2 q8_; q8_.x = pack4_fp8(y[0], y[1], y[2], y[3]); q8_.y = pack4_fp8(y[4], y[5], y[6], y[7]); *(u32x2*)(kf + h * 128 + c * 8) = q8_; }
    }
}

__device__ __forceinline__ void route_select(KP P, int layer, int T, int lane, bool& sel, float& w, int& rank) {
    const float* lp = (const float*)(P->ws + WS_ARENA + AR_LOGIT4) + (size_t)T * 64 + lane;
    const float x = (lp[0] + lp[(size_t)MT * 64]) + (lp[(size_t)2 * MT * 64] + lp[(size_t)3 * MT * 64]);
    const float s = 1.f / (1.f + __expf(-x));
    const float bsc = s + P->in[I_MOE_BR][layer * 64 + lane];
    float m1 = bsc;
#pragma unroll
    for (int o = 1; o < 8; o <<= 1) m1 = fmaxf(m1, __shfl_xor(m1, o));
    int i1 = (bsc == m1) ? lane : 64;
#pragma unroll
    for (int o = 1; o < 8; o <<= 1) i1 = min(i1, __shfl_xor(i1, o));
    float m2 = (lane == i1) ? -INFINITY : bsc;
#pragma unroll
    for (int o = 1; o < 8; o <<= 1) m2 = fmaxf(m2, __shfl_xor(m2, o));
    const float gs = m1 + m2; const int g = lane >> 3;
    int grank = 0;
#pragma unroll
    for (int q = 0; q < 8; ++q) { const float o = __shfl(gs, q * 8); grank += (o > gs || (o == gs && q < g)) ? 1 : 0; }
    const bool gsel = grank < 4;
    const float mb = gsel ? bsc : -INFINITY;
    rank = 0;
    for (int q = 0; q < 64; ++q) { const float o = __uint_as_float(__builtin_amdgcn_readlane((int)__float_as_uint(mb), q)); rank += (o > mb || (o == mb && q < lane)) ? 1 : 0; }
    sel = gsel && rank < 8;
    const float wsum = wave_sum(sel ? s : 0.f);
    w = s / wsum * 2.5f;
}
template <bool LAT> __device__ __forceinline__ void route_phase(KP P, int layer, LAS unsigned char* lds, int ntok, int vcu, int G, int wave, int lane, int tid) {
    constexpr int MAXS = 12;
    LAS int* hist = (LAS int*)lds; LAS int* base = hist + 64; LAS int* stash = base + 64; LAS float* stashw = (LAS float*)(stash + MAXS * 8 * 64);
    unsigned char* ws = P->ws; int* cnt = (int*)(ws + WS_CTL) + CW_CNT + layer * 64 * CNT_STRIDE;
    int* list = (int*)(ws + WS_LIST); float* wlist = (float*)(ws + WS_WLIST); int* asg = (int*)(ws + WS_ASG);
    const int nstep_all = (ntok + G * 8 - 1) / (G * 8);
    for (int s0 = 0; s0 < nstep_all; s0 += MAXS) {
        const int ns = (nstep_all - s0) < MAXS ? (nstep_all - s0) : MAXS;
        if (tid < 64) hist[tid] = 0;
        LDS_WAIT(); __syncthreads();
        for (int i = 0; i < ns; ++i) { const int j = ((s0 + i) * G + vcu) * 8 + wave; int pk = 0; float w = 0.f;
            if (j < ntok) { const int T = LAT ? (j >> 11) * TPB + CTXL + (j & 2047) : j; bool sel; int rank; route_select(P, layer, T, lane, sel, w, rank);
                if (sel) { const int ls = __hip_atomic_fetch_add(hist + lane, 1, __ATOMIC_RELAXED, __HIP_MEMORY_SCOPE_WORKGROUP); pk = ls | (rank << 20) | (1 << 31); } }
            stash[(i * 8 + wave) * 64 + lane] = pk; stashw[(i * 8 + wave) * 64 + lane] = w; }
        LDS_WAIT(); __syncthreads();
        if (tid < 64) { const int h = hist[tid]; base[tid] = h ? atomicAdd(cnt + tid * CNT_STRIDE, h) : 0; }
        LDS_WAIT(); __syncthreads();
        for (int i = 0; i < ns; ++i) { const int j = ((s0 + i) * G + vcu) * 8 + wave;
            if (j < ntok) { const int T = LAT ? (j >> 11) * TPB + CTXL + (j & 2047) : j; const int pk = stash[(i * 8 + wave) * 64 + lane];
                if (pk < 0) { const int slot = base[lane] + (pk & 0xfffff), rank = (pk >> 20) & 15;
                    list[(size_t)lane * CAP + slot] = T; wlist[(size_t)lane * CAP + slot] = stashw[(i * 8 + wave) * 64 + lane]; asg[(size_t)T * 8 + rank] = (lane << 16) | slot; } } }
        __syncthreads();
    }
}

__device__ __forceinline__ void moe_prefix(const int* cnt, LAS int* ublk, int tid) {
    if (tid < 64) { const int nb = (cnt[tid * CNT_STRIDE] + 255) >> 8; int inc = nb;
#pragma unroll
        for (int o = 1; o < 64; o <<= 1) { const int t = __shfl_up(inc, o); if (tid >= o) inc += t; }
        ublk[tid] = inc - nb; if (tid == 63) ublk[64] = inc; }
    LDS_WAIT(); __syncthreads();
    { const int tot = ublk[64]; LAS unsigned short* bexp = (LAS unsigned short*)(ublk + 128);
      for (int mbg = tid; mbg < tot; mbg += NTHREADS) { int lo = 0, hi = NEXP - 1;
          while (lo < hi) { const int mid = (lo + hi + 1) >> 1; if (ublk[mid] <= mbg) lo = mid; else hi = mid - 1; }
          bexp[mbg] = (unsigned short)lo; } }
    LDS_WAIT(); __syncthreads();
}

__device__ __forceinline__ void comb_mod_load(KP P, int layer, int r, int lane, float (&gtv)[4][8], float (&gg1)[4][8], float (&s01)[4][8]) {
    const float* mod = (const float*)(P->ws + WS_CTL + CTL_MOD) + ((size_t)layer * 9 + r) * NMOD; const float* gt = mod + 5 * DM;
#pragma unroll
    for (int j = 0; j < 4; ++j) { const int c = j * 512 + lane * 8; const f32x4 g0 = *(const f32x4*)(gt + c), g1 = *(const f32x4*)(gt + c + 4);
#pragma unroll
        for (int i = 0; i < 4; ++i) { gtv[j][i] = g0[i]; gtv[j][4 + i] = g1[i]; } }
    if (layer == 0) { const float* mod1 = (const float*)(P->ws + WS_CTL + CTL_MOD) + ((size_t)9 + r) * NMOD; const float* g = P->in[I_N1G] + DM;
#pragma unroll
        for (int j = 0; j < 4; ++j) { const int c = j * 512 + lane * 8;
#pragma unroll
            for (int q = 0; q < 2; ++q) { const f32x4 gv = *(const f32x4*)(g + c + 4 * q), sc = *(const f32x4*)(mod1 + DM + c + 4 * q), sh = *(const f32x4*)(mod1 + c + 4 * q);
#pragma unroll
                for (int i = 0; i < 4; ++i) { gg1[j][4 * q + i] = gv[i] * (1.f + sc[i]); s01[j][4 * q + i] = sh[i]; } } } }
}
__device__ __forceinline__ void combine_row(KP P, int layer, int T, int sh_block, const LAS int* ublk, int lane, const float (&gtv)[4][8], const float (&gg1)[4][8], const float (&s01)[4][8]) {
    unsigned char* ws = P->ws;
    int b, p, r; row_info(T, b, p, r);
    bf16* h = (bf16*)(ws + WS_H) + (size_t)T * DM; const int* asg = (const int*)(ws + WS_ASG) + (size_t)T * 8;
    float a[4][8];
#pragma unroll
    for (int j = 0; j < 4; ++j)
#pragma unroll
        for (int i = 0; i < 8; ++i) a[j][i] = 0.f;
    const int my = asg[lane & 7];
    const unsigned char* Y8 = (const unsigned char*)(ws + WS_ARENA + AR_Y);
#pragma unroll 4
    for (int k = 0; k < 8; ++k) {
        const int v = __builtin_amdgcn_readlane(my, k);
        const unsigned char* yp = Y8 + ((size_t)ublk[v >> 16] * 256 + (v & 0xffff)) * DM + lane * 8;
        u32x2 w[4];
#pragma unroll
        for (int j = 0; j < 4; ++j) w[j] = __builtin_nontemporal_load((const u32x2*)(yp + j * 512));
#pragma unroll
        for (int j = 0; j < 4; ++j) { const f32x2 p0 = __builtin_amdgcn_cvt_pk_f32_fp8((int)w[j].x, false), p1 = __builtin_amdgcn_cvt_pk_f32_fp8((int)w[j].x, true),
                                                  p2 = __builtin_amdgcn_cvt_pk_f32_fp8((int)w[j].y, false), p3 = __builtin_amdgcn_cvt_pk_f32_fp8((int)w[j].y, true);
            a[j][0] += p0[0]; a[j][1] += p0[1]; a[j][2] += p1[0]; a[j][3] += p1[1]; a[j][4] += p2[0]; a[j][5] += p2[1]; a[j][6] += p3[0]; a[j][7] += p3[1]; }
    }
    { const unsigned char* yp = (const unsigned char*)(ws + WS_ARENA + AR_YS) + (size_t)T * DM + lane * 8;
        u32x2 w[4];
#pragma unroll
        for (int j = 0; j < 4; ++j) w[j] = *(const u32x2*)(yp + j * 512);
#pragma unroll
        for (int j = 0; j < 4; ++j) { const f32x2 p0 = __builtin_amdgcn_cvt_pk_f32_fp8((int)w[j].x, false), p1 = __builtin_amdgcn_cvt_pk_f32_fp8((int)w[j].x, true),
                                                  p2 = __builtin_amdgcn_cvt_pk_f32_fp8((int)w[j].y, false), p3 = __builtin_amdgcn_cvt_pk_f32_fp8((int)w[j].y, true);
            a[j][0] += p0[0]; a[j][1] += p0[1]; a[j][2] += p1[0]; a[j][3] += p1[1]; a[j][4] += p2[0]; a[j][5] += p2[1]; a[j][6] += p3[0]; a[j][7] += p3[1]; }
#pragma unroll
        for (int j = 0; j < 4; ++j)
#pragma unroll
            for (int i = 0; i < 8; ++i) a[j][i] *= (1.f / Y_SCALE); }
    float ss = 0.f;
#pragma unroll
    for (int j = 0; j < 4; ++j) { const int c = j * 512 + lane * 8;
        float hx[8]; unpack8(*(const u32x4*)(h + c), hx);
#pragma unroll
        for (int i = 0; i < 8; ++i) a[j][i] = hx[i] + gtv[j][i] * a[j][i];
#pragma unroll
        for (int i = 0; i < 8; ++i) ss += a[j][i] * a[j][i]; }
    if (layer == 1) { float* o = P->out + ((size_t)b * SEQ + (p - CTXL)) * DM;
#pragma unroll
        for (int j = 0; j < 4; ++j) { const int c = j * 512 + lane * 8; *(f32x4*)(o + c) = (f32x4){a[j][0], a[j][1], a[j][2], a[j][3]}; *(f32x4*)(o + c + 4) = (f32x4){a[j][4], a[j][5], a[j][6], a[j][7]}; }
        return; }
    const float rs = __builtin_amdgcn_rsqf(wave_sum(ss) * (1.f / DM) + EPS);
    unsigned char* ao = (unsigned char*)(ws + WS_ACT) + (size_t)T * DM;
#pragma unroll
    for (int j = 0; j < 4; ++j) { const int c = j * 512 + lane * 8;
        *(u32x4*)(h + c) = pack8f(a[j]);
        float y[8];
#pragma unroll
        for (int i = 0; i < 8; ++i) y[i] = a[j][i] * rs * gg1[j][i] + s01[j][i];
        u32x2 q8; q8.x = pack4_fp8(y[0], y[1], y[2], y[3]); q8.y = pack4_fp8(y[4], y[5], y[6], y[7]); *(u32x2*)(ao + c) = q8; }
}

enum Phase { PH_P0 = 0, PH_NORM1, PH_DOWN, PH_UP, PH_FIN0, PH_ATT0, PH_WO0, PH_NORM2_0, PH_ROUTER0, PH_TOPK0, PH_G1_0, PH_G2_0, PH_COMB0,
             PH_QKV, PH_FIN1, PH_ATT1, PH_WO1, PH_NORM2_1, PH_ROUTER1, PH_TOPK1, PH_G1_1, PH_G2_1, PH_COMB1, PH_COUNT };

#ifndef LB2
#define LB2 2
#endif
__global__ void __launch_bounds__(NTHREADS, LB2) mega_fwd(Params P_unused) {
    extern __shared__ __attribute__((aligned(16))) unsigned char lds_raw[];
    const KP P0 = (KP)__builtin_amdgcn_kernarg_segment_ptr();
    LAS unsigned char* lds = (LAS unsigned char*)lds_raw;
    volatile LAS unsigned* MISC = (volatile LAS unsigned*)(lds + LDS_MISC);
    LAS int* ublk = (LAS int*)(lds + LDS_MISC + 64);
    const int wave0 = __builtin_amdgcn_readfirstlane(threadIdx.x >> 6);
    if (threadIdx.x < 2) MISC[threadIdx.x] = 0u;
    __syncthreads();
    XcdBarrier bar; bar.bar = (unsigned*)(P0->ws + WS_CTL) + CW_BAR; bar.x = 0; bar.st = nullptr;
    bar.wave = wave0;
    if (!MK_PER_PHASE) bar = xcd_barrier_post((unsigned*)(P0->ws + WS_CTL) + CW_BAR, MISC, wave0);
    const int lo = P0->ph_lo, hi = P0->ph_hi;
#ifndef PH_MASK
#define PH_MASK 0xFFFFFFFFu
#endif
#define IN(k) ((((PH_MASK) >> (k)) & 1u) && lo <= (k) && (k) < hi)
#define PH_BEGIN KP P = P0; asm volatile("" : "+s"(P)); int lane = lane_id(); asm volatile("" : "+v"(lane)); \
    const int wave = wave0, tid = wave * 64 + lane; \
    const int G = gridDim.x, bx = blockIdx.x, vcu = (G % 8 == 0) ? (bx % 8) * (G / 8) + bx / 8 : bx, gw = vcu * NWAVES + wave, NGW = G * NWAVES; \
    unsigned char* ws = P->ws; unsigned char* ar = ws + WS_ARENA; unsigned* ctl = (unsigned*)(ws + WS_CTL); \
    float* mod = (float*)(ws + WS_CTL + CTL_MOD); float* ssq = (float*)(ws + WS_SSQP); bf16* hbuf = (bf16*)(ws + WS_H); \
    (void)tid; (void)gw; (void)NGW; (void)ar; (void)ctl; (void)mod; (void)ssq; (void)hbuf; (void)vcu; (void)bx
#define SEAM(k) do { if (IN(k) && IN((k) + 1)) xcd_barrier(bar); } while (0)

    if (IN(PH_P0)) { PH_BEGIN; p0_prologue(P, lds, vcu, G, gw, NGW, wave, lane); } SEAM(PH_P0);

    if (IN(PH_NORM1)) { PH_BEGIN;
        bf16* A = (bf16*)(ar + AR_A);
        const int per = (MT + NGW - 1) / NGW, T1 = (gw + 1) * per < MT ? (gw + 1) * per : MT; int rcur = -1; f32x4 gg[8], s0[8];
        for (int T = gw * per; T < T1; ++T) { int b, p, r; row_info(T, b, p, r);
            if (r != rcur) { const float* m = mod + (size_t)r * NMOD; mod_load(P->in[I_N1G], m, m + DM, lane, gg, s0); rcur = r; }
            const float* src = p < CTXL ? P->in[I_CTX] + ((size_t)b * CTXL + p) * DM : P->in[I_X] + ((size_t)b * SEQ + (p - CTXL)) * DM;
            f32x4 v[8]; row_load(src, lane, v); norm_apply(v, gg, s0, lane, nullptr, (unsigned char*)A + (size_t)T * DM); }
    } SEAM(PH_NORM1);
    if (IN(PH_DOWN)) { PH_BEGIN;
        DenseSched S{(const char*)(ws + WS_BT_DOWN), (size_t)256 * 2048, NPAN, 6, G, bx, 0, 0};
        EpiDown E{(unsigned char*)(ar + AR_DOWN), ssq};
        pg8::gemm_phase<EpiDown, DenseSched, true>(wave, lds, (const char*)(ar + AR_A), DM, DM, S, E);
    } SEAM(PH_DOWN);
    if (IN(PH_UP)) { PH_BEGIN;
        { DenseSched S{(const char*)(ws + WS_BT_UQ), (size_t)256 * 768, NPAN, 12, G, bx, 0, 0};
          EpiScaleBf16 E{(bf16*)(ar + AR_QRAW), 3072, nullptr, 0, 0, 1.f / W2_SCALE, 1.f};
          pg8::gemm_phase<EpiScaleBf16, DenseSched, true>(wave, lds, (const char*)(ar + AR_DOWN), 1536, 768, S, E); }
        { DenseSched S{(const char*)(ws + WS_BT_UKV), (size_t)256 * 512, NPAN, 16, G, (bx + G / 2) % G, 0, 0};
          EpiKV E{(bf16*)(ar + AR_KVRAW), (unsigned char*)(ar + AR_KF), (const unsigned char*)(ar + AR_DOWN), ssq, P->in[I_MLA_GKN], lds};
          pg8::gemm_phase<EpiKV, DenseSched, true>(wave, lds, (const char*)(ar + AR_DOWN) + 768, 1536, 512, S, E); }
    } SEAM(PH_UP);
    if (IN(PH_ATT0)) { PH_BEGIN;
        const bf16* QF = (const bf16*)(ar + AR_QRAW); const bf16* KF = (const bf16*)(ar + AR_KF); const bf16* KV = (const bf16*)(ar + AR_KVRAW); unsigned char* O = (unsigned char*)(ar + AR_O);
        const float scale = 0.07216878364870322f;
        const int slot = (bx >> 3) % 5;     int ui = 0;
        for (int u = vcu; u < 1024 + 128 || ui <= slot; u += G, ++ui) {
            if (ui == slot) { __syncthreads(); cvt_moe_blocks(P, (LAS float*)lds, 0, vcu, G, tid); __syncthreads(); }
            if (u >= 1024 + 128) continue;
            int b, h, q0, seq;
            if (u < 1024) { b = u >> 7; h = (u >> 3) & 15; q0 = CTXL + (u & 7) * 256; seq = TPB; } else { const int j = u - 1024; b = j >> 4; h = j & 15; q0 = 0; seq = CTXL; }
            const size_t rb = (size_t)b * TPB;
            att::attn_body8<192, 3072, 3072, 4096, 2048>(wave, QF + (rb + q0) * 3072 + h * 192, (const unsigned char*)KF + rb * 3072 + h * 192, KV + rb * 4096 + h * 256 + 128, O + (rb + q0) * 2048 + h * 128, seq, scale, P->in[I_MLA_GQN], q0 - CTXL, (char*)lds_raw);
        }
    } SEAM(PH_ATT0);
    if (IN(PH_WO0)) { PH_BEGIN;
        DenseSched S{(const char*)(ws + WS_BT_WO0), (size_t)256 * 2048, NPAN, 8, G, bx, 0, 0};
        EpiResid E{P->in[I_X], P->in[I_CTX], nullptr, hbuf, mod, 2 * DM, 1, 1.f / (W1_SCALE * O_SCALE)};
        pg8::gemm_phase<EpiResid, DenseSched, true>(wave, lds, (const char*)(ar + AR_O), DM, DM, S, E);
    } SEAM(PH_WO0);
    if (IN(PH_NORM2_0)) { PH_BEGIN;
        bf16* F = (bf16*)(ar + AR_A);
        const int per = (MT + NGW - 1) / NGW, T1 = (gw + 1) * per < MT ? (gw + 1) * per : MT; int rcur = -1; f32x4 gg[8], s0[8];
        for (int T = gw * per; T < T1; ++T) { int b, p, r; row_info(T, b, p, r);
            if (r != rcur) { const float* m = mod + (size_t)r * NMOD; mod_load(P->in[I_N2G], m + 3 * DM, m + 4 * DM, lane, gg, s0); rcur = r; }
            f32x4 v[8]; row_load_bf(hbuf + (size_t)T * DM, lane, v); norm_apply(v, gg, s0, lane, F + (size_t)T * DM, (unsigned char*)(ws + WS_F8) + (size_t)T * DM); }
    } SEAM(PH_NORM2_0);
    if (IN(PH_ROUTER0)) { PH_BEGIN;
        { RouterSched S{(const char*)(ws + WS_BT_R), NPAN, G, vcu, 0};
          EpiRouter E{(float*)(ar + AR_LOGIT4)};
          pg8::gemm_phase(wave, lds, (const char*)(ar + AR_A), DM * 2, DM * 2, S, E, 8); }
        { PanelSched S{(const char*)(ws + WS_BT_S1), (size_t)256 * 2048, NPAN - 8, 4, G, vcu, 0, 8};
          EpiActS E{(unsigned char*)(ws + WS_ACT + ACT_S_OFF)};
          pg8::gemm_phase<EpiActS, PanelSched, true>(wave, lds, (const char*)(ws + WS_F8), DM, DM, S, E); }
    } SEAM(PH_ROUTER0);
    if (IN(PH_TOPK0)) { PH_BEGIN; if (vcu == 0) for (int i = tid; i < 2048; i += NTHREADS) { ((int*)(ws + WS_IDENT))[i] = i; ((float*)(ws + WS_IDENT + (size_t)NEXP * CAP * 4))[i] = ACT_SCALE / ACT_SCALE_R; }
        route_phase<false>(P, 0, lds, MT, vcu, G, wave, lane, tid); } SEAM(PH_TOPK0);
    if (IN(PH_G1_0)) { PH_BEGIN;
        const int* cnt = (const int*)ctl + CW_CNT; moe_prefix(cnt, ublk, tid);
        { MoeSched<true> S{(const float*)(ws + WS_WLIST), ublk, cnt, (const int*)(ws + WS_LIST), (const char*)(ws + WS_MOE1), (size_t)1024 * 2048, (const char*)(ws + WS_BT_S1), (size_t)256 * 2048, 4, 8, 0, G, vcu};
          EpiAct E{(unsigned char*)(ws + WS_ACT), lds, (unsigned char*)(ws + WS_ACT + ACT_S_OFF)};
          pg8::gemm_phase<EpiAct, MoeSched<true>, true>(wave, lds, (const char*)(ws + WS_F8), DM, DM, S, E); }
    } SEAM(PH_G1_0);
    if (IN(PH_G2_0)) { PH_BEGIN;
        const int* cnt = (const int*)ctl + CW_CNT; moe_prefix(cnt, ublk, tid);
        { MoeSched<false> S{nullptr, ublk, cnt, nullptr, (const char*)(ws + WS_MOE2), (size_t)2048 * 512, (const char*)(ws + WS_MOE2), (size_t)256 * 512, 8, 0, 0, G, vcu};
          EpiY E{(unsigned char*)(ar + AR_Y), Y_SCALE / (ACT_SCALE_R * W2_SCALE)};
          pg8::gemm_phase<EpiY, MoeSched<false>, true>(wave, lds, (const char*)(ws + WS_ACT), DEXP, DEXP, S, E); }
        { DenseSched S{(const char*)(ws + WS_BT_S2), (size_t)256 * 512, NPAN, 8, G, (bx + G / 2) % G, 0, 0};
          EpiY E{(unsigned char*)(ar + AR_YS), Y_SCALE / (ACT_SCALE * W2_SCALE)};
          pg8::gemm_phase<EpiY, DenseSched, true>(wave, lds, (const char*)(ws + WS_ACT + ACT_S_OFF), DEXP, DEXP, S, E); }
    } SEAM(PH_G2_0);
    if (IN(PH_COMB0)) { PH_BEGIN;
        const int* cnt = (const int*)ctl + CW_CNT; moe_prefix(cnt, ublk, tid);
        const int tot = ublk[64];
        const int per = (MT + NGW - 1) / NGW, T1 = (gw + 1) * per < MT ? (gw + 1) * per : MT; int rcur = -1; float gtv[4][8], gg1[4][8], s01[4][8];
        for (int T = gw * per; T < T1; ++T) { int b, p, r; row_info(T, b, p, r); if (r != rcur) { comb_mod_load(P, 0, r, lane, gtv, gg1, s01); rcur = r; }
            combine_row(P, 0, T, tot + (T >> 8), ublk, lane, gtv, gg1, s01); }
    } SEAM(PH_COMB0);

    if (IN(PH_QKV)) { PH_BEGIN;
        DenseSched S{(const char*)(ws + WS_BT_QKV), (size_t)256 * 2048, NPAN_LAT, 12, G, bx, 1, 32};
        EpiQKV1 E{(bf16*)(ar + AR_QRAW), (unsigned char*)(ar + AR_KF), P->in[I_GQA_GKN], lds};
        pg8::gemm_phase<EpiQKV1, DenseSched, true>(wave, lds, (const char*)(ws + WS_ACT), DM, DM, S, E);
    } SEAM(PH_QKV);
    if (IN(PH_ATT1)) { PH_BEGIN;
        const bf16* QF = (const bf16*)(ar + AR_QF); const bf16* KF = (const bf16*)(ar + AR_KF); const bf16* RAW = (const bf16*)(ar + AR_QRAW); unsigned char* O = (unsigned char*)(ar + AR_O);
        const float scale = 0.08838834764831845f;
        const int slot = (bx >> 3) % 5;     int ui = 0;
        for (int u = vcu; u < 1024 || ui <= slot; u += G, ++ui) {
            if (ui == slot) { __syncthreads(); cvt_moe_blocks(P, (LAS float*)lds, 1, vcu, G, tid); __syncthreads(); }
            if (u >= 1024) continue;
            const int b = u >> 7, h = (u >> 3) & 15, q0 = CTXL + (u & 7) * 256, kvh = h >> 2; const size_t rb = (size_t)b * TPB;
            att::attn_body8<128, 3072, 512, 3072, 2048>(wave, RAW + (rb + q0) * 3072 + h * 128, (const unsigned char*)KF + rb * 512 + kvh * 128, RAW + rb * 3072 + 2560 + kvh * 128, O + (rb + q0) * 2048 + h * 128, TPB, scale, P->in[I_GQA_GQN], q0 - CTXL, (char*)lds_raw);
        }
    } SEAM(PH_ATT1);
    if (IN(PH_WO1)) { PH_BEGIN;
        DenseSched S{(const char*)(ws + WS_BT_WO1), (size_t)256 * 2048, NPAN_LAT, 8, G, bx, 1, 0};
        EpiResid E{nullptr, nullptr, hbuf, hbuf, mod + (size_t)9 * NMOD, 2 * DM, 0, 1.f / (W1_SCALE * O_SCALE)};
        pg8::gemm_phase<EpiResid, DenseSched, true>(wave, lds, (const char*)(ar + AR_O), DM, DM, S, E);
    } SEAM(PH_WO1);
    if (IN(PH_NORM2_1)) { PH_BEGIN;
        bf16* F = (bf16*)(ar + AR_A);
        const int per = (NBATCH * SEQ + NGW - 1) / NGW, j1 = (gw + 1) * per < NBATCH * SEQ ? (gw + 1) * per : NBATCH * SEQ; int rcur = -1; f32x4 gg[8], s0[8];
        for (int j = gw * per; j < j1; ++j) { const int b = j >> 11, T = b * TPB + CTXL + (j & 2047);
            if (b != rcur) { const float* m = mod + (size_t)(9 + b) * NMOD; mod_load(P->in[I_N2G] + DM, m + 3 * DM, m + 4 * DM, lane, gg, s0); rcur = b; }
            f32x4 v[8]; row_load_bf(hbuf + (size_t)T * DM, lane, v); norm_apply(v, gg, s0, lane, F + (size_t)T * DM, (unsigned char*)(ws + WS_F8) + (size_t)T * DM); }
    } SEAM(PH_NORM2_1);
    if (IN(PH_ROUTER1)) { PH_BEGIN;
        { RouterSched S{(const char*)(ws + WS_BT_R) + (size_t)256 * 2048 * 2, NPAN_LAT, G, vcu, 1};
          EpiRouter E{(float*)(ar + AR_LOGIT4)};
          pg8::gemm_phase(wave, lds, (const char*)(ar + AR_A), DM * 2, DM * 2, S, E, 8); }
        { PanelSched S{(const char*)(ws + WS_BT_S1) + (size_t)1024 * 2048, (size_t)256 * 2048, NPAN_LAT, 4, G, vcu, 1};
          EpiActS E{(unsigned char*)(ws + WS_ACT + ACT_S_OFF)};
          pg8::gemm_phase<EpiActS, PanelSched, true>(wave, lds, (const char*)(ws + WS_F8), DM, DM, S, E); }
    } SEAM(PH_ROUTER1);
    if (IN(PH_TOPK1)) { PH_BEGIN; route_phase<true>(P, 1, lds, NBATCH * SEQ, vcu, G, wave, lane, tid); } SEAM(PH_TOPK1);
    if (IN(PH_G1_1)) { PH_BEGIN;
        const int* cnt = (const int*)ctl + CW_CNT + 64 * CNT_STRIDE; moe_prefix(cnt, ublk, tid);
        { MoeSched<true> S{(const float*)(ws + WS_WLIST), ublk, cnt, (const int*)(ws + WS_LIST), (const char*)(ws + WS_MOE1) + (size_t)64 * 1024 * 2048, (size_t)1024 * 2048, (const char*)(ws + WS_MOE1), (size_t)256 * 2048, 4, 0, 1, G, vcu};
          EpiAct E{(unsigned char*)(ws + WS_ACT), lds};
          pg8::gemm_phase<EpiAct, MoeSched<true>, true>(wave, lds, (const char*)(ws + WS_F8), DM, DM, S, E); }
    } SEAM(PH_G1_1);
    if (IN(PH_G2_1)) { PH_BEGIN;
        const int* cnt = (const int*)ctl + CW_CNT + 64 * CNT_STRIDE; moe_prefix(cnt, ublk, tid);
        { MoeSched<false> S{nullptr, ublk, cnt, nullptr, (const char*)(ws + WS_MOE2) + (size_t)64 * 2048 * 512, (size_t)2048 * 512, (const char*)(ws + WS_MOE2), (size_t)256 * 512, 8, 0, 1, G, vcu};
          EpiY E{(unsigned char*)(ar + AR_Y), Y_SCALE / (ACT_SCALE_R * W2_SCALE)};
          pg8::gemm_phase<EpiY, MoeSched<false>, true>(wave, lds, (const char*)(ws + WS_ACT), DEXP, DEXP, S, E); }
        { DenseSched S{(const char*)(ws + WS_BT_S2) + (size_t)2048 * 512, (size_t)256 * 512, NPAN_LAT, 8, G, (bx + G / 2) % G, 1, 0};
          EpiY E{(unsigned char*)(ar + AR_YS), Y_SCALE / (ACT_SCALE * W2_SCALE)};
          pg8::gemm_phase<EpiY, DenseSched, true>(wave, lds, (const char*)(ws + WS_ACT + ACT_S_OFF), DEXP, DEXP, S, E); }
    } SEAM(PH_G2_1);
    if (IN(PH_COMB1)) { PH_BEGIN;
        const int* cnt = (const int*)ctl + CW_CNT + 64 * CNT_STRIDE; moe_prefix(cnt, ublk, tid);
        const int tot = ublk[64];
        const int per = (NBATCH * SEQ + NGW - 1) / NGW, j1 = (gw + 1) * per < NBATCH * SEQ ? (gw + 1) * per : NBATCH * SEQ; int rcur = -1; float gtv[4][8], gg1[4][8], s01[4][8];
        for (int j = gw * per; j < j1; ++j) { const int b = j >> 11, T = b * TPB + CTXL + (j & 2047); if (b != rcur) { comb_mod_load(P, 1, b, lane, gtv, gg1, s01); rcur = b; }
            combine_row(P, 1, T, tot + (j >> 8), ublk, lane, gtv, gg1, s01); }
    }
#undef IN
#undef SEAM
}

extern "C" void kernel_launch(void* const* d_in, const int* in_sizes, int n_in, void* d_out, int out_size, void* d_ws, size_t ws_size, hipStream_t stream) {
    static int grid = 0;
    if (grid == 0) {
        if (n_in != 28 || ws_size < WS_END) { fprintf(stderr, "kernel_launch: expected 28 inputs and >= %zu bytes of workspace; got %d, %zu\n", (size_t)WS_END, n_in, ws_size); grid = -1; return; }
        int dev = 0, cus = 0, per_cu = 0;
        if (hipGetDevice(&dev) != hipSuccess || hipDeviceGetAttribute(&cus, hipDeviceAttributeMultiprocessorCount, dev) != hipSuccess) { grid = -1; return; }
        if (hipFuncSetAttribute((const void*)mega_fwd, hipFuncAttributeMaxDynamicSharedMemorySize, LDS_BYTES) != hipSuccess) { fprintf(stderr, "kernel_launch: hipFuncSetAttribute failed\n"); grid = -1; return; }
        if (hipOccupancyMaxActiveBlocksPerMultiprocessor(&per_cu, (const void*)mega_fwd, NTHREADS, LDS_BYTES) != hipSuccess || per_cu < 1) { fprintf(stderr, "kernel_launch: occupancy query reports %d\n", per_cu); }
        (void)hipGetLastError();
        grid = cus;
    }
    if (grid < 0) return;
    (void)hipMemsetAsync((char*)d_ws + WS_CTL, 0, CTL_BYTES, stream);
    Params p{};
    for (int i = 0; i < 28; ++i) p.in[i] = (const float*)d_in[i];
    p.out = (float*)d_out; p.ws = (unsigned char*)d_ws;
#if MK_PER_PHASE
    for (int ph = 0; ph < PH_COUNT; ++ph) { p.ph_lo = ph; p.ph_hi = ph + 1; hipLaunchKernelGGL(mega_fwd, dim3(grid), dim3(NTHREADS), LDS_BYTES, stream, p); }
#else
    p.ph_lo = 0; p.ph_hi = PH_COUNT;
    hipLaunchKernelGGL(mega_fwd, dim3(grid), dim3(NTHREADS), LDS_BYTES, stream, p);
#endif
    const hipError_t le = hipPeekAtLastError();
    if (le != hipSuccess) fprintf(stderr, "kernel_launch: launch failed: %s\n", hipGetErrorName(le));
}
```
